# Optimizing an MI355X kernel written in HIP

```python
import jax, jax.numpy as jnp
from jax import lax
import numpy as np

D_MODEL = 1024
BATCH = 16
SEQ = 4096
DEPTH = 2

N_A_LAYERS = DEPTH // 2
N_B_LAYERS = DEPTH - N_A_LAYERS

ROPE_THETA = 10000.0
EPS = 1e-6
Q_BLOCK = 128
ADA_INIT = 0.5

A_HEADS = 16
A_LATENT = 128
A_ROPE = 32
A_VDIM = 128
A_WIDTH = A_HEADS * A_VDIM
IDX_HEADS = 8
IDX_DIM = 64
TOPK_MAX = 256
A_SIZES = (A_HEADS * A_LATENT, A_HEADS * A_ROPE, A_LATENT, A_ROPE, A_WIDTH,
           IDX_HEADS * IDX_DIM, IDX_DIM, IDX_HEADS)
A_IN = sum(A_SIZES)

B_HEADS = 8
B_HDIM = 128
B_GROUPS = ((128, 1), (512, 4), (2048, 16))
N_GROUPS = len(B_GROUPS)
B_WIDTH = B_HEADS * B_HDIM
B_IN = N_GROUPS * B_WIDTH + B_WIDTH
KV_OUT = 2 * B_WIDTH

kernel_name = "yoco_dsa_longnet_hybrid"


def rmsnorm(x, g):
    xf = x.astype(jnp.float32)
    y = xf * lax.rsqrt(jnp.mean(xf * xf, axis=-1, keepdims=True) + EPS)
    return (y * g.astype(jnp.float32)).astype(x.dtype)


def rope_tables(positions, dim):
    inv = ROPE_THETA ** (-jnp.arange(0, dim, 2, dtype=jnp.float32) / dim)
    ang = positions.astype(jnp.float32)[..., None] * inv
    return jnp.cos(ang)[:, :, None, :], jnp.sin(ang)[:, :, None, :]


def apply_rope(x, cs):
    cos, sin = cs
    xf = x.astype(jnp.float32)
    x1, x2 = jnp.split(xf, 2, axis=-1)
    return jnp.concatenate([x1 * cos - x2 * sin, x2 * cos + x1 * sin], axis=-1).astype(x.dtype)


def split_cols(t, sizes):
    out, o = [], 0
    for s in sizes:
        out.append(t[..., o:o + s])
        o += s
    return out


def ada_prenorm(h, c, g, ada_w, ada_b):
    mod = (jax.nn.silu(c) @ ada_w + ada_b)[:, None, :]
    shift, scale, gate = jnp.split(mod, 3, axis=-1)
    return rmsnorm(h, g) * (1 + scale) + shift, gate


def dsa_mixer(h, positions, w_in, kv_norm_g, w_uv, w_out):
    B_, S, _ = h.shape
    q_lat, q_rope, c_kv, k_rope, gate, q_idx, k_idx, w_idx = split_cols(h @ w_in, A_SIZES)
    rope_a = rope_tables(positions, A_ROPE)
    q_lat = q_lat.reshape(B_, S, A_HEADS, A_LATENT)
    q_rope = apply_rope(q_rope.reshape(B_, S, A_HEADS, A_ROPE), rope_a)
    c_kv = rmsnorm(c_kv, kv_norm_g)
    k_rope = apply_rope(k_rope[:, :, None, :], rope_a)[:, :, 0]
    keys = jnp.concatenate([c_kv, k_rope], axis=-1)
    qcat = jnp.concatenate([q_lat, q_rope], axis=-1)
    rope_i = rope_tables(positions, IDX_DIM)
    q_idx = apply_rope(q_idx.reshape(B_, S, IDX_HEADS, IDX_DIM), rope_i)
    k_idx = apply_rope(k_idx[:, :, None, :], rope_i)[:, :, 0]
    w_idx = w_idx * IDX_HEADS ** -0.5
    topk = min(TOPK_MAX, S // 4)
    nblk = S // Q_BLOCK
    key_pos = jnp.arange(S)
    scale = (A_LATENT + A_ROPE) ** -0.5

    def to_blocks(t):
        return t.reshape(B_, nblk, Q_BLOCK, *t.shape[2:]).swapaxes(0, 1)

    def block(args):
        qb, qib, wb, start = args
        qpos = start + jnp.arange(Q_BLOCK)
        rel = jax.nn.relu(jnp.einsum('bqhd,bsd->bqhs', qib, k_idx))
        iscore = jnp.einsum('bqh,bqhs->bqs', wb, rel).astype(jnp.float32)
        causal = key_pos[None, :] <= qpos[:, None]
        iscore = jnp.where(causal[None], iscore, -jnp.inf)
        _, sel = lax.top_k(iscore, topk)
        gk = jax.vmap(lambda kb, ib: kb[ib])(keys, sel)
        s = jnp.einsum('bqhd,bqkd->bqhk', qb, gk).astype(jnp.float32) * scale
        valid = (sel <= qpos[None, :, None])[:, :, None, :]
        p = jax.nn.softmax(jnp.where(valid, s, -jnp.inf), axis=-1)
        return jnp.einsum('bqhk,bqkc->bqhc', p.astype(gk.dtype), gk[..., :A_LATENT])

    starts = jnp.arange(nblk, dtype=jnp.int32) * Q_BLOCK
    o_lat = lax.map(block, (to_blocks(qcat), to_blocks(q_idx), to_blocks(w_idx), starts))
    o_lat = o_lat.swapaxes(0, 1).reshape(B_, S, A_HEADS, A_LATENT)
    o = jnp.einsum('bshc,hcv->bshv', o_lat, w_uv).reshape(B_, S, A_WIDTH)
    return (o * jax.nn.silu(gate)) @ w_out


def shared_kv(h, positions, g, w_kv):
    B_, S, _ = h.shape
    k, v = jnp.split(rmsnorm(h, g) @ w_kv, 2, axis=-1)
    k = apply_rope(k.reshape(B_, S, B_HEADS, B_HDIM), rope_tables(positions, B_HDIM))
    return k, v.reshape(B_, S, B_HEADS, B_HDIM)


def dilated_band_attention(q, k, v, dilation, window):
    B_, S, H, Dh = q.shape
    W = window // dilation
    n = S // dilation
    nb = -(-n // W)
    n_pad = nb * W

    def sub(t):
        t = t.reshape(B_, n, dilation, H, Dh).swapaxes(1, 2).reshape(B_ * dilation, n, H, Dh)
        return jnp.pad(t, ((0, 0), (0, n_pad - n), (0, 0), (0, 0)))

    def with_prev(t):
        tb = t.reshape(-1, nb, W, H, Dh)
        prev = jnp.pad(tb, ((0, 0), (1, 0), (0, 0), (0, 0), (0, 0)))[:, :-1]
        return jnp.concatenate([prev, tb], axis=2)

    qb = sub(q).reshape(-1, nb, W, H, Dh)
    kb, vb = with_prev(sub(k)), with_prev(sub(v))
    s = jnp.einsum('znqhd,znkhd->znhqk', qb, kb).astype(jnp.float32) * Dh ** -0.5
    qpos = jnp.arange(nb)[:, None] * W + jnp.arange(W)[None, :]
    kpos = jnp.arange(nb)[:, None] * W - W + jnp.arange(2 * W)[None, :]
    dist = qpos[:, :, None] - kpos[:, None, :]
    mask = (dist >= 0) & (dist <= W) & (kpos[:, None, :] >= 0)
    s = jnp.where(mask[None, :, None], s, -jnp.inf)
    lse = jax.nn.logsumexp(s, axis=-1)
    p = jnp.exp(s - lse[..., None])
    o = jnp.einsum('znhqk,znkhd->znqhd', p.astype(v.dtype), vb)
    o = o.reshape(B_, dilation, n_pad, H, Dh)[:, :, :n].swapaxes(1, 2).reshape(B_, S, H, Dh)
    lse = lse.transpose(0, 1, 3, 2).reshape(B_, dilation, n_pad, H)[:, :, :n]
    lse = lse.swapaxes(1, 2).reshape(B_, S, H)
    return o, lse


def dilated_mixer(h, positions, k_sh, v_sh, w_in, w_out):
    B_, S, _ = h.shape
    proj = h @ w_in
    parts = split_cols(proj, (B_WIDTH,) * N_GROUPS + (B_WIDTH,))
    gate = parts[-1]
    rope_b = rope_tables(positions, B_HDIM)
    outs, lses = [], []
    for qg, (window, dil) in zip(parts[:-1], B_GROUPS):
        q = apply_rope(qg.reshape(B_, S, B_HEADS, B_HDIM), rope_b)
        o, lse = dilated_band_attention(q, k_sh, v_sh, dil, window)
        outs.append(o.astype(jnp.float32))
        lses.append(lse)
    alpha = jax.nn.softmax(jnp.stack(lses, axis=-1), axis=-1)
    o = jnp.einsum('bshg,gbshd->bshd', alpha, jnp.stack(outs)).astype(h.dtype)
    return (o.reshape(B_, S, B_WIDTH) * jax.nn.silu(gate)) @ w_out


def setup_inputs(seed: int = 0) -> dict:
    key = jax.random.key(seed)
    ks = jax.random.split(key, 18)
    D = D_MODEL

    def nrm(k, shape, fan_in):
        return jax.random.normal(k, shape, jnp.float32) * fan_in ** -0.5

    def gain(k, shape):
        return 1.0 + 0.05 * jax.random.normal(k, shape, jnp.float32)

    positions = (jax.random.randint(ks[2], (BATCH, 1), 0, 1024, dtype=jnp.int32)
                 + jnp.arange(SEQ, dtype=jnp.int32)[None, :])
    return {
        "x": jax.random.normal(ks[0], (BATCH, SEQ, D), jnp.float32),
        "c": jax.random.normal(ks[1], (BATCH, D), jnp.float32),
        "positions": positions,
        "a_norm": gain(ks[3], (N_A_LAYERS, D)),
        "a_ada_w": nrm(ks[4], (N_A_LAYERS, D, 3 * D), D) * ADA_INIT,
        "a_ada_b": 0.02 * jax.random.normal(ks[5], (N_A_LAYERS, 3 * D), jnp.float32),
        "a_w_in": nrm(ks[6], (N_A_LAYERS, D, A_IN), D),
        "a_kv_norm": gain(ks[7], (N_A_LAYERS, A_LATENT)),
        "a_w_uv": nrm(ks[8], (N_A_LAYERS, A_HEADS, A_LATENT, A_VDIM), A_LATENT),
        "a_w_out": nrm(ks[9], (N_A_LAYERS, A_WIDTH, D), A_WIDTH),
        "kv_norm": gain(ks[10], (D,)),
        "w_kv": nrm(ks[11], (D, KV_OUT), D),
        "b_norm": gain(ks[12], (N_B_LAYERS, D)),
        "b_ada_w": nrm(ks[13], (N_B_LAYERS, D, 3 * D), D) * ADA_INIT,
        "b_ada_b": 0.02 * jax.random.normal(ks[14], (N_B_LAYERS, 3 * D), jnp.float32),
        "b_w_in": nrm(ks[15], (N_B_LAYERS, D, B_IN), D),
        "b_w_out": nrm(ks[16], (N_B_LAYERS, B_WIDTH, D), B_WIDTH),
        "final_norm": gain(ks[17], (D,)),
    }


def reference(x, c, positions, a_norm, a_ada_w, a_ada_b, a_w_in, a_kv_norm, a_w_uv, a_w_out,
              kv_norm, w_kv, b_norm, b_ada_w, b_ada_b, b_w_in, b_w_out, final_norm):
    h = x
    k_sh = v_sh = None
    for i in range(DEPTH):
        if i < N_A_LAYERS:
            hn, g = ada_prenorm(h, c, a_norm[i], a_ada_w[i], a_ada_b[i])
            h = h + g * dsa_mixer(hn, positions, a_w_in[i], a_kv_norm[i], a_w_uv[i], a_w_out[i])
        else:
            if i == N_A_LAYERS:
                k_sh, v_sh = shared_kv(h, positions, kv_norm, w_kv)
            j = i - N_A_LAYERS
            hn, g = ada_prenorm(h, c, b_norm[j], b_ada_w[j], b_ada_b[j])
            h = h + g * dilated_mixer(hn, positions, k_sh, v_sh, b_w_in[j], b_w_out[j])
    return rmsnorm(h, final_norm)
```

```cpp
#include <hip/hip_runtime.h>
#include <hip/hip_cooperative_groups.h>
#include <cstdio>
#include <cstdint>
namespace cg = cooperative_groups;

namespace pg8 {
#define PG8_LAS __attribute__((address_space(3)))
typedef unsigned short bf16_t;
typedef short bf16x8 __attribute__((ext_vector_type(8)));
typedef float f32x4 __attribute__((ext_vector_type(4)));
typedef unsigned u32x4 __attribute__((ext_vector_type(4)));
constexpr int BM = 256, BK = 64, HALF = 128, HTB = HALF * BK * 2  , STAGE_BYTES = 8 * HTB, NXCD = 8, WGM = 8;

__host__ __device__ __forceinline__ int lds_byte(int r, int c) { const int st = (r >> 4) * 2 + (c >> 5), rr = r & 15, cc = c & 31, ob = rr * 64 + cc * 2; return st * 1024 + (ob ^ (((ob >> 9) & 1) << 5)); }
__host__ __device__ __forceinline__ void stage_rc(int b, int& R, int& C) { const int st = b / 1024, sb = b % 1024, swz = sb ^ (((sb >> 9) & 1) << 5); R = (st >> 1) * 16 + swz / 64; C = (st & 1) * 32 + (swz % 64) / 2; }
__host__ __device__ __forceinline__ int perm32(int rho) { const int n = rho >> 4, i = rho & 15; return 8 * (i >> 2) + 4 * n + (i & 3); }

struct Unit { int pm, pn; };
struct Gemm { const bf16_t* A; const bf16_t* Bt; int M, N, K, lda, ldb, aoff_pn; };

struct StaticOrder {
    int nM, nN, nwg, G, c;
    __host__ __device__ void init(int M, int N, int G_, int c_) { nM = M / BM; nN = N / BM; nwg = nM * nN; G = G_; c = c_; }
    __host__ __device__ bool next(int i, Unit& u) const {
        const long L = (long)i * G + c; if (L >= nwg) return false;
        int wgid = (int)L; { const int q = nwg / NXCD, r = nwg % NXCD, xcd = wgid % NXCD, off = wgid / NXCD; wgid = (xcd < r ? xcd * (q + 1) : r * (q + 1) + (xcd - r) * q) + off; }
        const int nig = WGM * nN, gid = wgid / nig, fm = gid * WGM, gsz = (nM - fm) < WGM ? (nM - fm) : WGM;
        u.pm = fm + ((wgid % nig) % gsz); u.pn = (wgid % nig) / gsz; return true;
    }
    __device__ __forceinline__ void a_ready(const Unit&) const {}
    __device__ __forceinline__ void done(const Unit&) const {}
};

__device__ __forceinline__ int opaque_lane() { int l; asm volatile("v_mbcnt_lo_u32_b32 %0, -1, 0\n\tv_mbcnt_hi_u32_b32 %0, -1, %0" : "=v"(l)); return l; }
template <class Epi, class Sched, bool SPLIT = false, bool STAMP = false>
__device__ __forceinline__ void gemm_phase(PG8_LAS unsigned char* lds, const Gemm g, const Sched& S, const Epi& E, unsigned long long* stamps, const int wave_in) {
    const int lane = opaque_lane(), wid = wave_in, tid = wid * 64 + lane, wr = wid >> 2, wc = wid & 3, fr = lane & 15, fq = lane >> 4;
    const int K = g.K, nt = SPLIT ? 48 : K / BK; const int lda = g.lda, ldb = g.ldb;
    int ts_lo = 0, ts_hi = 0, nts = 0; const unsigned long long rt_entry = STAMP ? (unsigned long long)wall_clock64() : 0ull;
#define PG8_STAMP() do { if (STAMP && wid == 0 && nts < 64) { const unsigned long long _c = (unsigned long long)clock64(); \
        ts_lo = (lane == nts) ? (int)(unsigned)_c : ts_lo; ts_hi = (lane == nts) ? (int)(unsigned)(_c >> 32) : ts_hi; ++nts; } } while (0)
    PG8_STAMP();
    unsigned voffA[2], voffB[2];
#pragma unroll
    for (int i = 0; i < 2; ++i) { int R, C; stage_rc(tid * 16 + i * 8192, R, C); const int Rb = Epi::PERM ? ((R & ~31) + perm32(R & 31)) : R;
        voffA[i] = (unsigned)(R * lda + C) * 2u; voffB[i] = (unsigned)(Rb * ldb + C) * 2u; }
    const size_t kstep = (size_t)(BK * 2);
    const size_t hstepA = (size_t)HALF * lda * 2, hstepB = (size_t)HALF * ldb * 2;
    const size_t tstepA = 2 * hstepA, tstepB = 2 * hstepB, pnoffA = (size_t)g.aoff_pn * 2;
    const unsigned ldsw = (unsigned)wid * 1024u;
    const int aoff = lds_byte(wr * 64 + fr, fq * 8), boff = lds_byte(wc * 32 + fr, fq * 8);
#define PG8_SA(b, h) (((b) * 2 + (h)) * HTB)
#define PG8_SB(b, h) ((4 + (b) * 2 + (h)) * HTB)
#define PG8_STAGE(bufoff, gbase, voff) do { _Pragma("unroll") for (int _i = 0; _i < 2; ++_i) \
        __builtin_amdgcn_global_load_lds((const unsigned*)((const char*)(gbase) + (voff)[_i]), (PG8_LAS unsigned*)(lds + (bufoff) + ldsw + _i * 8192), 16, 0, 0); } while (0)
#define PG8_LDA(dst, b, h) do { _Pragma("unroll") for (int m = 0; m < 4; ++m) _Pragma("unroll") for (int k = 0; k < 2; ++k) dst[m][k] = *(const PG8_LAS bf16x8*)(lds + PG8_SA(b, h) + aoff + m * 2048 + k * 1024); } while (0)
#define PG8_LDB(dst, b, h) do { _Pragma("unroll") for (int n = 0; n < 2; ++n) _Pragma("unroll") for (int k = 0; k < 2; ++k) dst[n][k] = *(const PG8_LAS bf16x8*)(lds + PG8_SB(b, h) + boff + n * 2048 + k * 1024); } while (0)
#define PG8_MMA(ai, bj, At, Bt) do { __builtin_amdgcn_s_setprio(1); _Pragma("unroll") for (int m = 0; m < 4; ++m) _Pragma("unroll") for (int n = 0; n < 2; ++n) _Pragma("unroll") for (int k = 0; k < 2; ++k) \
        acc[ai][bj][m][n] = __builtin_amdgcn_mfma_f32_16x16x32_bf16(Bt[n][k], At[m][k], acc[ai][bj][m][n], 0, 0, 0); __builtin_amdgcn_s_setprio(0); } while (0)
#define PG8_WAIT_V(n) asm volatile("s_waitcnt vmcnt(" #n ")" ::: "memory")
#define PG8_WAIT_L(n) asm volatile("s_waitcnt lgkmcnt(" #n ")" ::: "memory")
#define PG8_BAR __builtin_amdgcn_s_barrier()
#define PG8_SCHED __builtin_amdgcn_sched_barrier(0)
#define KTA(t) (SPLIT ? ((t) < 32 ? (t) : (t) - 32) : (t))
#define KTB(t) (SPLIT ? ((t) < 16 ? (t) : (t) - 16) : (t))
    Unit cur, nxt; int ui = 0;
    if (!S.next(0, cur)) return;
    f32x4 acc[2][2][4][2];
#pragma unroll
    for (int a = 0; a < 2; ++a)
#pragma unroll
        for (int b = 0; b < 2; ++b)
#pragma unroll
            for (int m = 0; m < 4; ++m)
#pragma unroll
                for (int n = 0; n < 2; ++n) acc[a][b][m][n] = (f32x4){0.f, 0.f, 0.f, 0.f};
    bf16x8 At[4][2], B0[2][2], B1[2][2];
    const char* cA = (const char*)g.A + (size_t)cur.pm * tstepA + (size_t)cur.pn * pnoffA; const char* cB = (const char*)g.Bt + (size_t)cur.pn * tstepB;
    S.a_ready(cur);
    PG8_STAGE(PG8_SB(0, 0), cB, voffB); PG8_STAGE(PG8_SA(0, 0), cA, voffA); PG8_STAGE(PG8_SB(0, 1), cB + hstepB, voffB); PG8_STAGE(PG8_SA(0, 1), cA + hstepA, voffA);
    if (wr == 1) PG8_BAR;
    PG8_WAIT_V(4); PG8_BAR;
    PG8_STAGE(PG8_SB(1, 0), cB + kstep, voffB); PG8_STAGE(PG8_SA(1, 0), cA + kstep, voffA); PG8_STAGE(PG8_SB(1, 1), cB + hstepB + kstep, voffB);
    PG8_WAIT_V(6); PG8_BAR;
    PG8_STAMP();
    for (;;) {
        const bool has_next = S.next(ui + 1, nxt);
        const char* nA = has_next ? (const char*)g.A + (size_t)nxt.pm * tstepA + (size_t)nxt.pn * pnoffA : cA; const char* nB = has_next ? (const char*)g.Bt + (size_t)nxt.pn * tstepB : cB;
        for (int t = 0; t < nt; t += 2) {
            const bool last = (t == nt - 2);
            const char* a1 = cA + (size_t)KTA(t + 1) * kstep;
            const char* a2 = last ? nA : cA + (size_t)KTA(t + 2) * kstep; const char* b2 = last ? nB : cB + (size_t)KTB(t + 2) * kstep;
            const char* a3 = a2 + kstep; const char* b3 = b2 + kstep;
            if (last && has_next) S.a_ready(nxt);
            PG8_LDB(B0, 0, 0); PG8_SCHED; PG8_LDA(At, 0, 0); PG8_STAGE(PG8_SA(1, 1), a1 + hstepA, voffA);
            PG8_WAIT_L(8); PG8_BAR; PG8_WAIT_L(0); PG8_MMA(0, 0, At, B0); PG8_BAR; PG8_SCHED;
            PG8_LDB(B1, 0, 1); PG8_STAGE(PG8_SB(0, 0), b2, voffB);
            PG8_BAR; PG8_WAIT_L(0); PG8_MMA(0, 1, At, B1); PG8_BAR;
            PG8_LDA(At, 0, 1); PG8_STAGE(PG8_SA(0, 0), a2, voffA);
            PG8_BAR; PG8_WAIT_L(0); PG8_MMA(1, 0, At, B0); PG8_BAR; PG8_SCHED;
            PG8_STAGE(PG8_SB(0, 1), b2 + hstepB, voffB);
            PG8_WAIT_V(6); PG8_BAR; PG8_MMA(1, 1, At, B1); PG8_BAR;
            PG8_LDB(B0, 1, 0); PG8_SCHED; PG8_LDA(At, 1, 0); PG8_STAGE(PG8_SA(0, 1), a2 + hstepA, voffA);
            PG8_WAIT_L(8); PG8_BAR; PG8_WAIT_L(0); PG8_MMA(0, 0, At, B0); PG8_BAR; PG8_SCHED;
            PG8_LDB(B1, 1, 1); PG8_STAGE(PG8_SB(1, 0), b3, voffB);
            PG8_BAR; PG8_WAIT_L(0); PG8_MMA(0, 1, At, B1); PG8_BAR;
            PG8_LDA(At, 1, 1); PG8_STAGE(PG8_SA(1, 0), a3, voffA);
            PG8_BAR; PG8_WAIT_L(0); PG8_MMA(1, 0, At, B0); PG8_BAR; PG8_SCHED;
            PG8_STAGE(PG8_SB(1, 1), b3 + hstepB, voffB);
            PG8_WAIT_V(6); PG8_BAR; PG8_MMA(1, 1, At, B1); PG8_BAR;
        }
        PG8_STAMP();
        if constexpr (!Epi::AFTER_DRAIN) { E(acc, cur, wr, wc, fr, fq); S.done(cur); }
        PG8_STAMP();
        if (!has_next) break;
#pragma unroll
        for (int a = 0; a < 2; ++a)
#pragma unroll
            for (int b = 0; b < 2; ++b)
#pragma unroll
                for (int m = 0; m < 4; ++m)
#pragma unroll
                    for (int n = 0; n < 2; ++n) acc[a][b][m][n] = (f32x4){0.f, 0.f, 0.f, 0.f};
        cur = nxt; cA = nA; cB = nB; ++ui;
    }
    PG8_WAIT_V(0);
    if (wr == 0) PG8_BAR;
    PG8_BAR;
    if constexpr (Epi::AFTER_DRAIN) { E.fused(acc, cur, wr, wc, fr, fq, lds, wid, lane); S.done(cur); }
    PG8_STAMP();
    if (STAMP && wid == 0) { stamps[lane] = lane < nts ? (((unsigned long long)(unsigned)ts_hi << 32) | (unsigned)ts_lo) : 0ull;
        if (lane == 62) stamps[62] = rt_entry; if (lane == 63) stamps[63] = (unsigned long long)wall_clock64(); }
#undef PG8_STAMP
#undef PG8_SA
#undef PG8_SB
#undef PG8_STAGE
#undef PG8_LDA
#undef PG8_LDB
#undef PG8_MMA
#undef PG8_WAIT_V
#undef PG8_WAIT_L
#undef PG8_BAR
#undef PG8_SCHED
#undef KTA
#undef KTB
}
}

using pg8::bf16_t; using pg8::bf16x8; using pg8::f32x4; using pg8::u32x4; using pg8::Unit;
#define LAS __attribute__((address_space(3)))
#define DI __device__ __forceinline__
typedef float f32x16 __attribute__((ext_vector_type(16)));
typedef unsigned u32x2 __attribute__((ext_vector_type(2)));
typedef float f32x2 __attribute__((ext_vector_type(2)));

constexpr int D = 1024, NB = 16, SEQ = 4096, M = NB * SEQ;
constexpr float EPS = 1e-6f;
constexpr size_t MBy = (size_t)1 << 20;
constexpr size_t OFF_WA_MAIN = 0, OFF_WA_IDX = 10 * MBy, OFF_WUV = 13 * MBy, OFF_WAO = 14 * MBy, OFF_WKV = 18 * MBy, OFF_WBI = 22 * MBy, OFF_WBO = 30 * MBy,
                 OFF_MOD = 32 * MBy, OFF_ROPE_A = 33 * MBy, OFF_ROPE_I = 41 * MBy, OFF_ROPE_B = 57 * MBy, OFF_ACT = 89 * MBy;
constexpr size_t OFF_QCAT = OFF_ACT, OFF_GATE = OFF_QCAT + 320 * MBy, OFF_QIDX = OFF_GATE + 256 * MBy, OFF_KEYS = OFF_QIDX + 128 * MBy, OFF_KIDX = OFF_KEYS + 20 * MBy,
                 OFF_WIDX = OFF_KIDX + 16 * MBy, OFF_CKV = OFF_WIDX + 2 * MBy, OFF_SC = OFF_CKV + 32 * MBy, END_A = OFF_SC + 128 * MBy;
constexpr size_t OFF_HNB = OFF_ACT, OFF_KB = OFF_HNB + 128 * MBy, OFF_VB = OFF_KB + 128 * MBy, OFF_Q3 = OFF_VB + 128 * MBy, OFF_GB = OFF_Q3 + 384 * MBy, OFF_HKV = OFF_GB,
                 OFF_LSE = OFF_GB + 128 * MBy, END_B = OFF_LSE + 6 * MBy;
constexpr size_t WS_NEED = END_A > END_B ? END_A : END_B;
constexpr size_t OFF_BAR = OFF_MOD + 768 * 1024;
constexpr int LDS_BYTES = 152 * 1024;
constexpr int MAX_GRID = 256;

struct Params {
    const float* in[18];
    float* out; unsigned char* ws;
};

typedef __bf16 bf16x2_t __attribute__((ext_vector_type(2)));
DI unsigned cvt_pk_bf16(float lo, float hi) { const f32x2 f = {lo, hi}; const bf16x2_t v = __builtin_convertvector(f, bf16x2_t); return __builtin_bit_cast(unsigned, v); }
DI float bflo(unsigned w) { return __uint_as_float(w << 16); }
DI float bfhi(unsigned w) { return __uint_as_float(w & 0xffff0000u); }
DI float wave_sum(float v) {
#pragma unroll
    for (int o = 1; o < 64; o <<= 1) v += __shfl_xor(v, o);
    return v;
}
DI float silu_f(float x) { return x * (1.0f / (1.0f + __expf(-x))); }
DI u32x2 pack4(const f32x4& v) { u32x2 w; w.x = cvt_pk_bf16(v[0], v[1]); w.y = cvt_pk_bf16(v[2], v[3]); return w; }
DI f32x4 unpack4(const u32x2& w) { return (f32x4){bflo(w.x), bfhi(w.x), bflo(w.y), bfhi(w.y)}; }
#define WAVE_LDS_FENCE() asm volatile("s_waitcnt lgkmcnt(0)" ::: "memory")

DI void rope4(const f32x4& x1, const f32x4& x2, const float* tab, float sc, f32x4& o1, f32x4& o2) {
    const f32x4 t0 = *(const f32x4*)tab, t1 = *(const f32x4*)(tab + 4);
    const f32x4 c = {t0[0], t0[2], t1[0], t1[2]}, s = {t0[1], t0[3], t1[1], t1[3]};
    o1 = (x1 * c - x2 * s) * sc; o2 = (x2 * c + x1 * s) * sc;
}

#define EPI_ROWS_BEGIN _Pragma("unroll") for (int ai = 0; ai < 2; ++ai) _Pragma("unroll") for (int m = 0; m < 4; ++m) { const int row = row0 + ai * 128 + m * 16;
#define EPI_ROWS_END asm volatile("" ::: "memory"); }

struct EpiAMain {
    static constexpr bool PERM = false, AFTER_DRAIN = false;
    bf16_t* qcat; bf16_t* gate; bf16_t* keys; float* ckv; const float* ropeA;
    DI void operator()(const f32x4 (&acc)[2][2][4][2], const Unit& u, int wr, int wc, int fr, int fq) const {
        const int row0 = u.pm * 256 + wr * 64 + fr; const float qs = 0.07905694150420949f;
        if (u.pn < 8) {
            EPI_ROWS_BEGIN
#pragma unroll
                for (int bj = 0; bj < 2; ++bj)
#pragma unroll
                    for (int n = 0; n < 2; ++n) { const f32x4 v = acc[ai][bj][m][n] * qs;
                        *(u32x2*)(qcat + (size_t)row * 2560 + (2 * u.pn + bj) * 160 + 32 * wc + 16 * n + 4 * fq) = pack4(v); }  EPI_ROWS_END
        } else if (u.pn < 10) {
            EPI_ROWS_BEGIN  const float* tab = ropeA + (size_t)row * 32 + 8 * fq;
#pragma unroll
                for (int bj = 0; bj < 2; ++bj) { f32x4 o1, o2; rope4(acc[ai][bj][m][0], acc[ai][bj][m][1], tab, qs, o1, o2);
                    bf16_t* dst = qcat + (size_t)row * 2560 + (8 * (u.pn - 8) + 4 * bj + wc) * 160 + 128 + 4 * fq;
                    *(u32x2*)dst = pack4(o1); *(u32x2*)(dst + 16) = pack4(o2); }  EPI_ROWS_END
        } else if (u.pn < 18) {
            EPI_ROWS_BEGIN
#pragma unroll
                for (int bj = 0; bj < 2; ++bj)
#pragma unroll
                    for (int n = 0; n < 2; ++n) { f32x4 v = acc[ai][bj][m][n];
#pragma unroll
                        for (int j = 0; j < 4; ++j) v[j] = silu_f(v[j]);
                        *(u32x2*)(gate + (size_t)row * 2048 + 256 * (u.pn - 10) + 128 * bj + 32 * wc + 16 * n + 4 * fq) = pack4(v); }  EPI_ROWS_END
        } else {
            EPI_ROWS_BEGIN
#pragma unroll
                for (int n = 0; n < 2; ++n) *(f32x4*)(ckv + (size_t)row * 128 + 32 * wc + 16 * n + 4 * fq) = acc[ai][0][m][n];
                if (wc == 0) { f32x4 o1, o2; rope4(acc[ai][1][m][0], acc[ai][1][m][1], ropeA + (size_t)row * 32 + 8 * fq, 1.0f, o1, o2);
                    bf16_t* dst = keys + (size_t)row * 160 + 128 + 4 * fq; *(u32x2*)dst = pack4(o1); *(u32x2*)(dst + 16) = pack4(o2); }  EPI_ROWS_END
        }
    }
};
DI void store_hilo(bf16_t* dst, const f32x4& o) {
    const u32x2 h = pack4(o); const f32x4 r = o - unpack4(h); *(u32x2*)dst = h; *(u32x2*)(dst + 64) = pack4(r);
}
struct EpiAIdx {
    static constexpr bool PERM = false, AFTER_DRAIN = false;
    bf16_t* qidx; bf16_t* kidx; float* widx; const float* ropeI;
    DI void operator()(const f32x4 (&acc)[2][2][4][2], const Unit& u, int wr, int wc, int fr, int fq) const {
        const int row0 = u.pm * 256 + wr * 64 + fr; const int a = wc & 1;
        if (u.pn < 2) {
            EPI_ROWS_BEGIN  const float* tab = ropeI + (size_t)row * 64 + 2 * (16 * a + 4 * fq);
#pragma unroll
                for (int bj = 0; bj < 2; ++bj) { f32x4 o1, o2; rope4(acc[ai][bj][m][0], acc[ai][bj][m][1], tab, 1.0f, o1, o2);
                    bf16_t* dst = qidx + (size_t)row * 1024 + (4 * u.pn + 2 * bj + (wc >> 1)) * 128 + 32 * a + 4 * fq;
                    store_hilo(dst, o1); store_hilo(dst + 16, o2); }  EPI_ROWS_END
        } else {
            EPI_ROWS_BEGIN
                if (wc < 2) { f32x4 o1, o2; rope4(acc[ai][0][m][0], acc[ai][0][m][1], ropeI + (size_t)row * 64 + 2 * (16 * a + 4 * fq), 1.0f, o1, o2);
                    bf16_t* dst = kidx + (size_t)row * 128 + 32 * a + 4 * fq; store_hilo(dst, o1); store_hilo(dst + 16, o2); }
                if (wc == 2 && fq < 2) *(f32x4*)(widx + (size_t)row * 8 + 4 * fq) = acc[ai][0][m][0] * 0.35355339059327373f;  EPI_ROWS_END
        }
    }
};
struct EpiUV {
    static constexpr bool PERM = false, AFTER_DRAIN = false;
    bf16_t* gate;
    DI void operator()(const f32x4 (&acc)[2][2][4][2], const Unit& u, int wr, int wc, int fr, int fq) const {
        const int row0 = u.pm * 256 + wr * 64 + fr;
        EPI_ROWS_BEGIN
#pragma unroll
            for (int bj = 0; bj < 2; ++bj)
#pragma unroll
                for (int n = 0; n < 2; ++n) { bf16_t* p = gate + (size_t)row * 2048 + 256 * u.pn + 128 * bj + 32 * wc + 16 * n + 4 * fq;
                    const f32x4 g = unpack4(*(const u32x2*)p); *(u32x2*)p = pack4(acc[ai][bj][m][n] * g); }  EPI_ROWS_END
    }
};
struct EpiRes {
    static constexpr bool PERM = false, AFTER_DRAIN = false;
    const float* base; float* out; const float* mgate;
    DI void operator()(const f32x4 (&acc)[2][2][4][2], const Unit& u, int wr, int wc, int fr, int fq) const {
        const int row0 = u.pm * 256 + wr * 64 + fr; const float* mg = mgate + (size_t)(u.pm >> 4) * 3072;
#pragma unroll
        for (int bj = 0; bj < 2; ++bj)
#pragma unroll
            for (int n = 0; n < 2; ++n) { const int col = 256 * u.pn + 128 * bj + 32 * wc + 16 * n + 4 * fq; const f32x4 gv = *(const f32x4*)(mg + col);
                EPI_ROWS_BEGIN  const size_t o = (size_t)row * 1024 + col; *(f32x4*)(out + o) = *(const f32x4*)(base + o) + gv * acc[ai][bj][m][n];  EPI_ROWS_END }
    }
};
struct EpiKV {
    static constexpr bool PERM = false, AFTER_DRAIN = false;
    bf16_t* kb; bf16_t* vb; const float* ropeB;
    DI void operator()(const f32x4 (&acc)[2][2][4][2], const Unit& u, int wr, int wc, int fr, int fq) const {
        const int row0 = u.pm * 256 + wr * 64 + fr;
        if (u.pn < 4) {
            EPI_ROWS_BEGIN  const float* tab = ropeB + (size_t)row * 128 + 2 * (16 * wc + 4 * fq);
#pragma unroll
                for (int bj = 0; bj < 2; ++bj) { f32x4 o1, o2; rope4(acc[ai][bj][m][0], acc[ai][bj][m][1], tab, 1.0f, o1, o2);
                    bf16_t* dst = kb + (size_t)row * 1024 + 256 * u.pn + 128 * bj + 32 * wc + 4 * fq; *(u32x2*)dst = pack4(o1); *(u32x2*)(dst + 16) = pack4(o2); }  EPI_ROWS_END
        } else {
            EPI_ROWS_BEGIN
#pragma unroll
                for (int bj = 0; bj < 2; ++bj)
#pragma unroll
                    for (int n = 0; n < 2; ++n) *(u32x2*)(vb + (size_t)row * 1024 + 256 * (u.pn - 4) + 128 * bj + 32 * wc + 16 * n + 4 * fq) = pack4(acc[ai][bj][m][n]);  EPI_ROWS_END
        }
    }
};
struct EpiBIn {
    static constexpr bool PERM = false, AFTER_DRAIN = false;
    bf16_t* q3; bf16_t* gb; const float* ropeB;
    DI void operator()(const f32x4 (&acc)[2][2][4][2], const Unit& u, int wr, int wc, int fr, int fq) const {
        const int row0 = u.pm * 256 + wr * 64 + fr;
        if (u.pn < 12) {
            bf16_t* qg = q3 + (size_t)(u.pn >> 2) * M * 1024;
            EPI_ROWS_BEGIN  const float* tab = ropeB + (size_t)row * 128 + 2 * (16 * wc + 4 * fq);
#pragma unroll
                for (int bj = 0; bj < 2; ++bj) { f32x4 o1, o2; rope4(acc[ai][bj][m][0], acc[ai][bj][m][1], tab, 0.08838834764831845f, o1, o2);
                    bf16_t* dst = qg + (size_t)row * 1024 + 256 * (u.pn & 3) + 128 * bj + 32 * wc + 4 * fq; *(u32x2*)dst = pack4(o1); *(u32x2*)(dst + 16) = pack4(o2); }  EPI_ROWS_END
        } else {
            EPI_ROWS_BEGIN
#pragma unroll
                for (int bj = 0; bj < 2; ++bj)
#pragma unroll
                    for (int n = 0; n < 2; ++n) { f32x4 v = acc[ai][bj][m][n];
#pragma unroll
                        for (int j = 0; j < 4; ++j) v[j] = silu_f(v[j]);
                        *(u32x2*)(gb + (size_t)row * 1024 + 256 * (u.pn - 12) + 128 * bj + 32 * wc + 16 * n + 4 * fq) = pack4(v); }  EPI_ROWS_END
        }
    }
};

DI int map_src_col(int mat, int n) {
    switch (mat) {
    case 0:
        if (n < 2560) return n;
        if (n < 4608) return 2720 + (n - 2560);
        if (n < 4736) return 2560 + (n - 4608);
        if (n < 4768) return 2688 + (n - 4736);
        return -1;
    case 1:
        if (n < 576) { const int hd = n >> 6, p = n & 63, a = p >> 5, nn = (p >> 4) & 1, i = p & 15; return 4768 + hd * 64 + nn * 32 + a * 16 + i; }
        if (n < 584) return 5344 + (n - 576);
        return -1;
    case 3: case 4: {
        const int lim = (mat == 3) ? 1024 : 3072;
        if (n < lim) { const int hd = n >> 7, p = n & 127, a = p >> 5, nn = (p >> 4) & 1, i = p & 15; return hd * 128 + nn * 64 + a * 16 + i; }
        return n; }
    default: return n;
    }
}
DI void transpose_tile(const float* W, int ldw, int k0, int srccol, bf16_t* dst  , int ldk, bool split, LAS float* scr, int lane) {
#pragma unroll 8
    for (int i = 0; i < 32; ++i) { const int kk = 2 * i + (lane >> 5); scr[kk * 33 + (lane & 31)] = srccol >= 0 ? W[(size_t)(k0 + kk) * ldw + srccol] : 0.0f; }
    WAVE_LDS_FENCE();
    const int c = lane & 7;
#pragma unroll
    for (int j = 0; j < 4; ++j) { const int n = (lane >> 3) + 8 * j; const LAS float* s = scr + (8 * c) * 33 + n;
        float v[8];
#pragma unroll
        for (int e = 0; e < 8; ++e) v[e] = s[e * 33];
        u32x4 h; h.x = cvt_pk_bf16(v[0], v[1]); h.y = cvt_pk_bf16(v[2], v[3]); h.z = cvt_pk_bf16(v[4], v[5]); h.w = cvt_pk_bf16(v[6], v[7]);
        *(u32x4*)(dst + (size_t)n * ldk + 8 * c) = h;
        if (split) { u32x4 l; l.x = cvt_pk_bf16(v[0] - bflo(h.x), v[1] - bfhi(h.x)); l.y = cvt_pk_bf16(v[2] - bflo(h.y), v[3] - bfhi(h.y));
            l.z = cvt_pk_bf16(v[4] - bflo(h.z), v[5] - bfhi(h.z)); l.w = cvt_pk_bf16(v[6] - bflo(h.w), v[7] - bfhi(h.w));
            *(u32x4*)(dst + (size_t)n * ldk + 1024 + 8 * c) = l; } }
    WAVE_LDS_FENCE();
}
DI double ipow(double base, int e) { double r = 1.0, b = base; for (int i = 0; i < 6; ++i) { if (e & 1) r *= b; b *= b; e >>= 1; } return r; }
DI void phase0(const Params& p, LAS unsigned char* lds, int tid, int wave, int lane) {
    unsigned char* ws = p.ws;
    const int G = gridDim.x, NW = G * 8, gw = blockIdx.x * 8 + wave;
    LAS float* sc = (LAS float*)lds;
    LAS float* scr = (LAS float*)(lds + 65536 + wave * 8448);
    if (blockIdx.x * 8 < 384) {
        for (int i = tid; i < NB * D; i += 512) { const int b = i >> 10, k = i & 1023; sc[k * 16 + b] = silu_f(p.in[1][i]); }
        __syncthreads();
    }
    constexpr int I_MOD = 384, I0 = 16 * 152, I1 = 16 * 24, I2 = 32 * 32, I3 = 16 * 64, I4 = 16 * 128, I5 = 16 * 32, I6 = 128;
    constexpr int NITEMS = I_MOD + I0 + I1 + I2 + I3 + I4 + I5 + I6;
    for (int it = gw; it < NITEMS; it += NW) {
        int r = it;
        if (r < I_MOD) {
            const int layer = r / 192, cgp = r % 192, col = cgp * 16 + (lane & 15), kp = lane >> 4;
            const float* Wm = p.in[layer ? 13 : 4]; const float* bias = p.in[layer ? 14 : 5];
            float acc[16];
#pragma unroll
            for (int b = 0; b < 16; ++b) acc[b] = 0.f;
#pragma unroll 4
            for (int k = kp * 256; k < kp * 256 + 256; ++k) { const float w = Wm[(size_t)k * 3072 + col];
                const f32x4 s0 = *(const LAS f32x4*)(sc + k * 16), s1 = *(const LAS f32x4*)(sc + k * 16 + 4), s2 = *(const LAS f32x4*)(sc + k * 16 + 8), s3 = *(const LAS f32x4*)(sc + k * 16 + 12);
#pragma unroll
                for (int j = 0; j < 4; ++j) { acc[j] += s0[j] * w; acc[4 + j] += s1[j] * w; acc[8 + j] += s2[j] * w; acc[12 + j] += s3[j] * w; } }
#pragma unroll
            for (int b = 0; b < 16; ++b) { acc[b] += __shfl_xor(acc[b], 16); acc[b] += __shfl_xor(acc[b], 32); }
            if (kp == 0) { float* mod = (float*)(ws + OFF_MOD) + (size_t)layer * NB * 3072; const float bv = bias[col];
#pragma unroll
                for (int b = 0; b < 16; ++b) mod[b * 3072 + col] = acc[b] + bv; }
            continue;
        }
        r -= I_MOD;
        int mat, K, ldw, ldk; const float* W; bf16_t* WT; bool split = false;
        if (r < I0) { mat = 0; W = p.in[6]; ldw = 5352; K = 1024; ldk = 1024; WT = (bf16_t*)(ws + OFF_WA_MAIN); }
        else if ((r -= I0) < I1) { mat = 1; W = p.in[6]; ldw = 5352; K = 1024; ldk = 2048; WT = (bf16_t*)(ws + OFF_WA_IDX); split = true; }
        else if ((r -= I1) < I2) { mat = 2; W = p.in[9]; ldw = 1024; K = 2048; ldk = 2048; WT = (bf16_t*)(ws + OFF_WAO); }
        else if ((r -= I2) < I3) { mat = 3; W = p.in[11]; ldw = 2048; K = 1024; ldk = 1024; WT = (bf16_t*)(ws + OFF_WKV); }
        else if ((r -= I3) < I4) { mat = 4; W = p.in[15]; ldw = 4096; K = 1024; ldk = 1024; WT = (bf16_t*)(ws + OFF_WBI); }
        else if ((r -= I4) < I5) { mat = 5; W = p.in[16]; ldw = 1024; K = 1024; ldk = 1024; WT = (bf16_t*)(ws + OFF_WBO); }
        else { r -= I5; mat = 6; W = nullptr; ldw = 128; K = 128; ldk = 256; WT = (bf16_t*)(ws + OFF_WUV); }
        if (mat < 6) {
            const int nkb = K / 64, kb = r % nkb, nb = r / nkb, n0 = nb * 32, k0 = kb * 64;
            const int srccol = map_src_col(mat, n0 + (lane & 31));
            transpose_tile(W, ldw, k0, srccol, WT + (size_t)n0 * ldk + k0, ldk, split, scr, lane);
        } else {
            const int h = r >> 3, cb = (r >> 2) & 1, vb = r & 3;
            bf16_t* dst = WT + (size_t)(h * 128 + vb * 32) * 256 + (h & 1) * 128 + cb * 64;
            transpose_tile(p.in[8] + (size_t)h * 16384, 128, cb * 64, vb * 32 + (lane & 31), dst, 256, false, scr, lane);
            bf16_t* dz = WT + (size_t)(h * 128 + vb * 32) * 256 + (1 - (h & 1)) * 128 + cb * 64;
            const int c = lane & 7;
#pragma unroll
            for (int j = 0; j < 4; ++j) { const int n = (lane >> 3) + 8 * j; *(u32x4*)(dz + (size_t)n * 256 + 8 * c) = (u32x4){0u, 0u, 0u, 0u}; }
        }
    }
    const int* pos = (const int*)p.in[2];
    for (size_t idx = (size_t)blockIdx.x * 512 + tid; idx < (size_t)M * 112; idx += (size_t)G * 512) {
        const int tok = (int)(idx / 112), e = (int)(idx % 112);
        double base; int f; float* dst;
        if (e < 16) { base = 0.5623413251903491; f = e; dst = (float*)(ws + OFF_ROPE_A) + ((size_t)tok * 16 + f) * 2; }
        else if (e < 48) { base = 0.7498942093324559; f = e - 16; dst = (float*)(ws + OFF_ROPE_I) + ((size_t)tok * 32 + f) * 2; }
        else { base = 0.8659643233600653; f = e - 48; dst = (float*)(ws + OFF_ROPE_B) + ((size_t)tok * 64 + f) * 2; }
        const double ang = (double)pos[tok] * ipow(base, f);
        const double kq = __builtin_rint(ang * 0.6366197723675814);
        double rr = __builtin_fma(-kq, 1.5707963267948966, ang); rr = __builtin_fma(-kq, 6.123233995736766e-17, rr);
        const double r2 = rr * rr;
        double sn = rr * (1.0 + r2 * (-1.0 / 6 + r2 * (1.0 / 120 + r2 * (-1.0 / 5040 + r2 * (1.0 / 362880 + r2 * (-1.0 / 39916800 + r2 * (1.0 / 6227020800.0)))))));
        double cs = 1.0 + r2 * (-0.5 + r2 * (1.0 / 24 + r2 * (-1.0 / 720 + r2 * (1.0 / 40320 + r2 * (-1.0 / 3628800 + r2 * (1.0 / 479001600.0 + r2 * (-1.0 / 87178291200.0)))))));
        const int q = (int)((long long)kq & 3);
        double co, si;
        if (q == 0) { co = cs; si = sn; } else if (q == 1) { co = -sn; si = cs; } else if (q == 2) { co = -cs; si = -sn; } else { co = sn; si = -cs; }
        *(f32x2*)dst = (f32x2){(float)co, (float)si};
    }
}

DI void phase_hnA(const Params& p, int wave, int lane) {
    const int NW = gridDim.x * 8, gw = blockIdx.x * 8 + wave;
    const float* x = p.in[0]; const float* g = p.in[3]; const float* mod = (const float*)(p.ws + OFF_MOD);
    bf16_t* HN = (bf16_t*)p.out;
    for (int row = gw; row < M; row += NW) {
        const int b = row >> 12; const f32x4* xr = (const f32x4*)(x + (size_t)row * 1024) + lane;
        f32x4 v[4]; float ss = 0.f;
#pragma unroll
        for (int j = 0; j < 4; ++j) { v[j] = xr[64 * j]; ss += (v[j][0] * v[j][0] + v[j][1] * v[j][1]) + (v[j][2] * v[j][2] + v[j][3] * v[j][3]); }
        const float rstd = 1.0f / sqrtf(wave_sum(ss) * (1.0f / 1024) + EPS);
#pragma unroll
        for (int j = 0; j < 4; ++j) { const int col = 256 * j + 4 * lane;
            const f32x4 gv = *(const f32x4*)(g + col), sh = *(const f32x4*)(mod + (size_t)b * 3072 + col), scv = *(const f32x4*)(mod + (size_t)b * 3072 + 1024 + col);
            const f32x4 y = (v[j] * rstd) * gv * (scv + 1.0f) + sh;
            const u32x2 h = pack4(y); const f32x4 rem = y - unpack4(h);
            *(u32x2*)(HN + (size_t)row * 2048 + col) = h; *(u32x2*)(HN + (size_t)row * 2048 + 1024 + col) = pack4(rem); }
    }
}
DI void phase_ckv(const Params& p, int wave, int lane) {
    const int NW = gridDim.x * 8, gw = blockIdx.x * 8 + wave;
    const float* ckv = (const float*)(p.ws + OFF_CKV); bf16_t* keys = (bf16_t*)(p.ws + OFF_KEYS); const float* g = p.in[7];
    const f32x2 gv = *(const f32x2*)(g + 2 * lane);
    for (int row = gw; row < M; row += NW) {
        const f32x2 v = *(const f32x2*)(ckv + (size_t)row * 128 + 2 * lane);
        const float rstd = 1.0f / sqrtf(wave_sum(v[0] * v[0] + v[1] * v[1]) * (1.0f / 128) + EPS);
        *(unsigned*)(keys + (size_t)row * 160 + 2 * lane) = cvt_pk_bf16(v[0] * rstd * gv[0], v[1] * rstd * gv[1]);
    }
}

#define MFMA32(a, b, c) __builtin_amdgcn_mfma_f32_32x32x16_bf16((a), (b), (c), 0, 0, 0)
#define MFMA16(a, b, c) __builtin_amdgcn_mfma_f32_16x16x32_bf16((a), (b), (c), 0, 0, 0)
DI bf16x8 pack8(const f32x4& a, const f32x4& b) { u32x4 w; w.x = cvt_pk_bf16(a[0], a[1]); w.y = cvt_pk_bf16(a[2], a[3]); w.z = cvt_pk_bf16(b[0], b[1]); w.w = cvt_pk_bf16(b[2], b[3]); return __builtin_bit_cast(bf16x8, w); }
DI bf16x8 ident_frag(int lane, int half) {
    const int n = lane & 15, g = lane >> 4; u32x4 w = {0u, 0u, 0u, 0u};
    if (g == 2 * half + (n >> 3)) { const int jj = n & 7; const unsigned one = (jj & 1) ? 0x3F800000u : 0x00003F80u;
        if ((jj >> 1) == 0) w.x = one; else if ((jj >> 1) == 1) w.y = one; else if ((jj >> 1) == 2) w.z = one; else w.w = one; }
    return __builtin_bit_cast(bf16x8, w);
}
DI unsigned mbcnt64(unsigned long long m) { return __builtin_amdgcn_mbcnt_hi((unsigned)(m >> 32), __builtin_amdgcn_mbcnt_lo((unsigned)m, 0u)); }

DI void phase_dsa(const Params& p, LAS unsigned char* lds, int tid, int wave, int lane) {
    unsigned char* ws = p.ws;
    const bf16_t* QIDX = (const bf16_t*)(ws + OFF_QIDX); const bf16_t* KIDX = (const bf16_t*)(ws + OFF_KIDX); const float* WIDX = (const float*)(ws + OFF_WIDX);
    bf16_t* QCAT = (bf16_t*)(ws + OFF_QCAT); const bf16_t* KEYS = (const bf16_t*)(ws + OFF_KEYS);
    float* SC = (float*)(ws + OFF_SC) + (size_t)blockIdx.x * (32 * 4096);
    LAS unsigned char* Qs = lds; LAS int* sel = (LAS int*)(lds + 66048 + wave * 1024);
    const int G = gridDim.x;
    const bf16x8 e0 = ident_frag(lane, 0), e1 = ident_frag(lane, 1);
    const float NEG_INF = -__builtin_huge_valf();
    for (int rd = 0;; ++rd) {
        const int t = rd * G + ((rd & 1) ? (G - 1 - (int)blockIdx.x) : (int)blockIdx.x); if (t >= 2048) break;
        int lo_ = lane; asm volatile("" : "+v"(lo_)); const int l31 = lo_ & 31, h2 = lo_ >> 5;
        const int qt = 127 - (t >> 4), b = t & 15, q0 = qt * 32; const size_t tok0 = (size_t)b * SEQ;
        int tid_ = tid; asm volatile("" : "+v"(tid_));
        for (int idx = tid_; idx < 32 * 128; idx += 512) { const int q = idx >> 7, ch = idx & 127;
            *(LAS u32x4*)(Qs + q * 2064 + ch * 16) = *(const u32x4*)(QIDX + (tok0 + q0 + q) * 1024 + ch * 8); }
        float wq[8];
        { const f32x4 w0 = *(const f32x4*)(WIDX + (tok0 + q0 + l31) * 8), w1 = *(const f32x4*)(WIDX + (tok0 + q0 + l31) * 8 + 4);
#pragma unroll
          for (int j = 0; j < 4; ++j) { wq[j] = w0[j]; wq[4 + j] = w1[j]; } }
        __syncthreads();
#ifndef DSA_NOSCORE
        for (int kt = wave; kt <= qt; kt += 8) {
            const bf16_t* kp = KIDX + (tok0 + kt * 32 + l31) * 128 + 8 * h2;
            bf16x8 Ah[4], Al[4];
#pragma unroll
            for (int kc = 0; kc < 4; ++kc) { Ah[kc] = *(const bf16x8*)(kp + 16 * kc); Al[kc] = *(const bf16x8*)(kp + 64 + 16 * kc); }
            f32x16 s;
#pragma unroll
            for (int i = 0; i < 16; ++i) s[i] = 0.f;
#pragma unroll
            for (int h = 0; h < 8; ++h) {
                f32x16 acc;
#pragma unroll
                for (int i = 0; i < 16; ++i) acc[i] = 0.f;
#pragma unroll
                for (int kc = 0; kc < 4; ++kc) {
                    const bf16x8 Bh = *(const LAS bf16x8*)(Qs + l31 * 2064 + h * 256 + (16 * kc + 8 * h2) * 2);
                    const bf16x8 Bl = *(const LAS bf16x8*)(Qs + l31 * 2064 + h * 256 + 128 + (16 * kc + 8 * h2) * 2);
                    acc = MFMA32(Ah[kc], Bh, acc); acc = MFMA32(Al[kc], Bh, acc); acc = MFMA32(Ah[kc], Bl, acc);
                }
#pragma unroll
                for (int i = 0; i < 16; ++i) s[i] += wq[h] * fmaxf(acc[i], 0.f);
                asm volatile("" ::: "memory");
            }
            float* dst = SC + (size_t)l31 * 4096 + kt * 32 + 4 * h2;
#pragma unroll
            for (int jj = 0; jj < 4; ++jj) *(f32x4*)(dst + 8 * jj) = (f32x4){s[4 * jj], s[4 * jj + 1], s[4 * jj + 2], s[4 * jj + 3]};
        }
#endif
        asm volatile("s_waitcnt vmcnt(0)" ::: "memory");
        __syncthreads();
#pragma unroll 1
        for (int qi = 0; qi < 4; ++qi) {
            const int ql = wave * 4 + qi, spos = q0 + ql, N = spos + 1; const size_t tok = tok0 + spos;
            int lv = lane; asm volatile("" : "+v"(lv)); const int ln = lv & 15, g4 = lv >> 4;
            int nvalid;
            if (N <= 256) {
                nvalid = N;
#pragma unroll
                for (int j = 0; j < 4; ++j) { const int k = j * 64 + lv; sel[k] = k < N ? k : 0; }
            } else {
                nvalid = 256;
#ifndef DSA_NOSEL
                const float* scq = SC + (size_t)ql * 4096;
                unsigned u[64];
#pragma unroll
                for (int j = 0; j < 64; ++j) { unsigned bits = __float_as_uint(__hip_atomic_load(scq + j * 64 + lv, __ATOMIC_RELAXED, __HIP_MEMORY_SCOPE_AGENT)); if (bits == 0x80000000u) bits = 0u;
                    const unsigned o = bits ^ ((bits >> 31) ? 0xFFFFFFFFu : 0x80000000u); u[j] = (lv < N - j * 64) ? o : 0u; }
                unsigned T = 0u;
#pragma unroll 1
                for (int bit = 31; bit >= 0; --bit) {
                    const unsigned cand = T | (1u << bit); int cnt = 0;
#pragma unroll
                    for (int j = 0; j < 64; ++j) cnt += __popcll(__ballot(u[j] >= cand));
                    if (cnt >= 256) { T = cand; if (cnt == 256) break; }
                }
                int cgt = 0;
#pragma unroll
                for (int j = 0; j < 64; ++j) cgt += __popcll(__ballot(u[j] > T));
                const int need = 256 - cgt; int base = 0, tbase = 0;
#pragma unroll
                for (int j = 0; j < 64; ++j) {
                    const bool gt = u[j] > T, eq = u[j] == T;
                    const unsigned long long em = __ballot(eq);
                    const bool take = gt || (eq && (tbase + (int)mbcnt64(em)) < need);
                    const unsigned long long tm = __ballot(take);
                    if (take) sel[base + (int)mbcnt64(tm)] = j * 64 + lv;
                    base += __popcll(tm); tbase += __popcll(em);
                }
#endif
            }
            WAVE_LDS_FENCE();
#ifdef DBG_DSA
            { float* dbg = p.out + tok * 1024;
#pragma unroll
              for (int j = 0; j < 4; ++j) dbg[j * 64 + lv] = (float)sel[j * 64 + lv];
              dbg[256 + lv] = (float)nvalid; }
#define DSA_NOATTN
#endif
#ifndef DSA_NOATTN
            const bf16_t* qp = QCAT + tok * 2560 + ln * 160 + 8 * g4;
            bf16x8 qf[5];
#pragma unroll
            for (int kc = 0; kc < 5; ++kc) qf[kc] = *(const bf16x8*)(qp + 32 * kc);
            const int npair = (nvalid + 31) >> 5;
            float m_run = NEG_INF, l_run = 0.f;
            f32x4 O[8];
#pragma unroll
            for (int d = 0; d < 8; ++d) O[d] = (f32x4){0.f, 0.f, 0.f, 0.f};
            bf16x8 f0[5], f1[5], n0[5], n1[5];
            { const bf16_t* kp0 = KEYS + (tok0 + sel[ln]) * 160 + 8 * g4; const bf16_t* kp1 = KEYS + (tok0 + sel[16 + ln]) * 160 + 8 * g4;
#pragma unroll
              for (int kc = 0; kc < 5; ++kc) { f0[kc] = *(const bf16x8*)(kp0 + 32 * kc); f1[kc] = *(const bf16x8*)(kp1 + 32 * kc); } }
#pragma unroll 1
            for (int up = 0; up < npair; ++up) {
                if (up + 1 < npair) {
                    const bf16_t* kp0 = KEYS + (tok0 + sel[32 * up + 32 + ln]) * 160 + 8 * g4; const bf16_t* kp1 = KEYS + (tok0 + sel[32 * up + 48 + ln]) * 160 + 8 * g4;
#pragma unroll
                    for (int kc = 0; kc < 5; ++kc) { n0[kc] = *(const bf16x8*)(kp0 + 32 * kc); n1[kc] = *(const bf16x8*)(kp1 + 32 * kc); }
                }
                f32x4 s0 = {0.f, 0.f, 0.f, 0.f}, s1 = {0.f, 0.f, 0.f, 0.f};
#pragma unroll
                for (int kc = 0; kc < 5; ++kc) { s0 = MFMA16(f0[kc], qf[kc], s0); s1 = MFMA16(f1[kc], qf[kc], s1); }
                const int sl = 32 * up + 4 * g4;
#pragma unroll
                for (int i = 0; i < 4; ++i) { s0[i] = (sl + i < nvalid) ? s0[i] : NEG_INF; s1[i] = (sl + 16 + i < nvalid) ? s1[i] : NEG_INF; }
                float tm = fmaxf(fmaxf(fmaxf(s0[0], s0[1]), fmaxf(s0[2], s0[3])), fmaxf(fmaxf(s1[0], s1[1]), fmaxf(s1[2], s1[3])));
                tm = fmaxf(tm, __shfl_xor(tm, 16)); tm = fmaxf(tm, __shfl_xor(tm, 32));
                const float m_new = fmaxf(m_run, tm), alpha = __expf(m_run - m_new); m_run = m_new;
                float ps = 0.f;
#pragma unroll
                for (int i = 0; i < 4; ++i) { s0[i] = __expf(s0[i] - m_new); s1[i] = __expf(s1[i] - m_new); ps += s0[i] + s1[i]; }
                l_run = l_run * alpha + ps;
#pragma unroll
                for (int i = 0; i < 4; ++i) { const float ai = __shfl(alpha, 4 * g4 + i);
#pragma unroll
                    for (int d = 0; d < 8; ++d) O[d][i] *= ai; }
                const bf16x8 pa = pack8(s0, s1);
                const f32x4 z = {0.f, 0.f, 0.f, 0.f};
#pragma unroll
                for (int kc = 0; kc < 4; ++kc) {
                    const f32x4 a0 = MFMA16(f0[kc], e0, z), a1 = MFMA16(f1[kc], e0, z), b0 = MFMA16(f0[kc], e1, z), b1 = MFMA16(f1[kc], e1, z);
                    O[2 * kc] = MFMA16(pa, pack8(a0, a1), O[2 * kc]);
                    O[2 * kc + 1] = MFMA16(pa, pack8(b0, b1), O[2 * kc + 1]);
                }
#pragma unroll
                for (int kc = 0; kc < 5; ++kc) { f0[kc] = n0[kc]; f1[kc] = n1[kc]; }
            }
            l_run += __shfl_xor(l_run, 16); l_run += __shfl_xor(l_run, 32);
            { const float inv = 1.0f / l_run;
#pragma unroll
              for (int i = 0; i < 4; ++i) { const float ii = __shfl(inv, 4 * g4 + i);
#pragma unroll
                  for (int d = 0; d < 8; ++d) O[d][i] *= ii; } }
            bf16_t* op = QCAT + tok * 2560 + ln;
#pragma unroll
            for (int d = 0; d < 8; ++d)
#pragma unroll
                for (int i = 0; i < 4; ++i) op[(4 * g4 + i) * 128 + 16 * d] = (bf16_t)(cvt_pk_bf16(O[d][i], 0.f) & 0xffffu);
#endif
            WAVE_LDS_FENCE();
        }
        __syncthreads();
    }
}

DI void phase_normB(const Params& p, int wave, int lane) {
    const int NW = gridDim.x * 8, gw = blockIdx.x * 8 + wave;
    const float* h = p.out; const float* gk = p.in[10]; const float* gb = p.in[12]; const float* mod = (const float*)(p.ws + OFF_MOD) + (size_t)NB * 3072;
    bf16_t* HKV = (bf16_t*)(p.ws + OFF_HKV); bf16_t* HNB = (bf16_t*)(p.ws + OFF_HNB);
    for (int row = gw; row < M; row += NW) {
        const int b = row >> 12; const f32x4* xr = (const f32x4*)(h + (size_t)row * 1024) + lane;
        f32x4 v[4]; float ss = 0.f;
#pragma unroll
        for (int j = 0; j < 4; ++j) { v[j] = xr[64 * j]; ss += (v[j][0] * v[j][0] + v[j][1] * v[j][1]) + (v[j][2] * v[j][2] + v[j][3] * v[j][3]); }
        const float rstd = 1.0f / sqrtf(wave_sum(ss) * (1.0f / 1024) + EPS);
#pragma unroll
        for (int j = 0; j < 4; ++j) { const int col = 256 * j + 4 * lane; const f32x4 nv = v[j] * rstd;
            const f32x4 g1 = *(const f32x4*)(gk + col), g2 = *(const f32x4*)(gb + col), sh = *(const f32x4*)(mod + (size_t)b * 3072 + col), scv = *(const f32x4*)(mod + (size_t)b * 3072 + 1024 + col);
            *(u32x2*)(HKV + (size_t)row * 1024 + col) = pack4(nv * g1);
            *(u32x2*)(HNB + (size_t)row * 1024 + col) = pack4(nv * g2 * (scv + 1.0f) + sh); }
    }
}

DI void phase_dil(const Params& p, int wave, int lane) {
    unsigned char* ws = p.ws;
    const int NW = gridDim.x * 8, gw = blockIdx.x * 8 + wave;
    const bf16_t* KB = (const bf16_t*)(ws + OFF_KB); const bf16_t* VB = (const bf16_t*)(ws + OFF_VB); bf16_t* Q3 = (bf16_t*)(ws + OFF_Q3); float* LSE = (float*)(ws + OFF_LSE);
    const int ln = lane & 15, g4 = lane >> 4;
    const bf16x8 e0 = ident_frag(lane, 0), e1 = ident_frag(lane, 1);
    const float NEG_INF = -__builtin_huge_valf();
#pragma unroll 1
    for (int it = gw; it < 98304; it += NW) {
        const int qt = it & 7; int r1 = it >> 3; const int blkres = r1 & 31; r1 >>= 5; const int head = r1 & 7; r1 >>= 3; const int grp = r1 % 3, b = r1 / 3;
        const int lg = grp * 2, nblk = 32 >> lg, res = blkres >> (5 - lg), blk = blkres & (nblk - 1);
        const int qsub0 = blk * 128 + qt * 16; const size_t tok0 = (size_t)b * SEQ;
        bf16_t* Qg = Q3 + (size_t)grp * M * 1024;
        const size_t tokq = tok0 + ((size_t)(qsub0 + ln) << lg) + res;
        bf16x8 qf[4];
#pragma unroll
        for (int kc = 0; kc < 4; ++kc) qf[kc] = *(const bf16x8*)(Qg + tokq * 1024 + head * 128 + 32 * kc + 8 * g4);
        f32x4 st[9];
#pragma unroll
        for (int tl = 0; tl < 9; ++tl) {
            const int ks = qsub0 - 128 + 16 * tl + ln; const size_t tokk = tok0 + ((size_t)(ks < 0 ? 0 : ks) << lg) + res;
            const bf16_t* kp = KB + tokk * 1024 + head * 128 + 8 * g4;
            f32x4 acc = {0.f, 0.f, 0.f, 0.f};
#pragma unroll
            for (int kc = 0; kc < 4; ++kc) acc = MFMA16(*(const bf16x8*)(kp + 32 * kc), qf[kc], acc);
#pragma unroll
            for (int i = 0; i < 4; ++i) { const int ksi = qsub0 - 128 + 16 * tl + 4 * g4 + i, dist = qsub0 + ln - ksi;
                st[tl][i] = (dist >= 0 && dist <= 128 && ksi >= 0) ? acc[i] : NEG_INF; }
        }
        float mx = NEG_INF;
#pragma unroll
        for (int tl = 0; tl < 9; ++tl) mx = fmaxf(fmaxf(fmaxf(st[tl][0], st[tl][1]), fmaxf(st[tl][2], st[tl][3])), mx);
        mx = fmaxf(mx, __shfl_xor(mx, 16)); mx = fmaxf(mx, __shfl_xor(mx, 32));
        float sum = 0.f;
#pragma unroll
        for (int tl = 0; tl < 9; ++tl)
#pragma unroll
            for (int i = 0; i < 4; ++i) { const float e = __expf(st[tl][i] - mx); st[tl][i] = e; sum += e; }
        sum += __shfl_xor(sum, 16); sum += __shfl_xor(sum, 32);
        const float inv = 1.0f / sum;
        if (g4 == 0) LSE[((size_t)grp * M + tokq) * 8 + head] = mx + __logf(sum);
        f32x4 O[8];
#pragma unroll
        for (int d = 0; d < 8; ++d) O[d] = (f32x4){0.f, 0.f, 0.f, 0.f};
#pragma unroll
        for (int up = 0; up < 5; ++up) {
            const int t0 = 2 * up, t1 = (2 * up + 1 < 9) ? 2 * up + 1 : 8;
            const int ks0 = qsub0 - 128 + 16 * t0 + ln, ks1 = qsub0 - 128 + 16 * t1 + ln;
            const bf16_t* vp0 = VB + (tok0 + ((size_t)(ks0 < 0 ? 0 : ks0) << lg) + res) * 1024 + head * 128 + 8 * g4;
            const bf16_t* vp1 = VB + (tok0 + ((size_t)(ks1 < 0 ? 0 : ks1) << lg) + res) * 1024 + head * 128 + 8 * g4;
            const f32x4 z = {0.f, 0.f, 0.f, 0.f};
            const bf16x8 pa = pack8(st[t0] * inv, (2 * up + 1 < 9) ? st[t1] * inv : z);
#pragma unroll
            for (int kc = 0; kc < 4; ++kc) {
                const bf16x8 v0 = *(const bf16x8*)(vp0 + 32 * kc), v1 = *(const bf16x8*)(vp1 + 32 * kc);
                const f32x4 a0 = MFMA16(v0, e0, z), a1 = MFMA16(v1, e0, z), b0 = MFMA16(v0, e1, z), b1 = MFMA16(v1, e1, z);
                O[2 * kc] = MFMA16(pa, pack8(a0, a1), O[2 * kc]);
                O[2 * kc + 1] = MFMA16(pa, pack8(b0, b1), O[2 * kc + 1]);
            }
        }
#pragma unroll
        for (int i = 0; i < 4; ++i) { bf16_t* op = Qg + (tok0 + ((size_t)(qsub0 + 4 * g4 + i) << lg) + res) * 1024 + head * 128 + ln;
#pragma unroll
            for (int d = 0; d < 8; ++d) op[16 * d] = (bf16_t)(cvt_pk_bf16(O[d][i], 0.f) & 0xffffu); }
    }
}
DI void phase_merge(const Params& p, int wave, int lane) {
    unsigned char* ws = p.ws;
    const int NW = gridDim.x * 8, gw = blockIdx.x * 8 + wave;
    const bf16_t* Q3 = (const bf16_t*)(ws + OFF_Q3); bf16_t* GB = (bf16_t*)(ws + OFF_GB); const float* LSE = (const float*)(ws + OFF_LSE);
    for (int row = gw; row < M; row += NW) {
        const int head = lane >> 3;
        const float l0 = LSE[((size_t)row) * 8 + head], l1 = LSE[((size_t)M + row) * 8 + head], l2 = LSE[((size_t)2 * M + row) * 8 + head];
        const float mx = fmaxf(l0, fmaxf(l1, l2)); float w0 = __expf(l0 - mx), w1 = __expf(l1 - mx), w2 = __expf(l2 - mx); const float inv = 1.0f / (w0 + w1 + w2);
        w0 *= inv; w1 *= inv; w2 *= inv;
        const size_t off = (size_t)row * 1024 + 16 * lane;
#pragma unroll
        for (int hh = 0; hh < 2; ++hh) {
            const u32x4 a = *(const u32x4*)(Q3 + off + 8 * hh), bq = *(const u32x4*)(Q3 + (size_t)M * 1024 + off + 8 * hh), cq = *(const u32x4*)(Q3 + (size_t)2 * M * 1024 + off + 8 * hh);
            const u32x4 gg = *(const u32x4*)(GB + off + 8 * hh); u32x4 o;
#pragma unroll
            for (int j = 0; j < 4; ++j) { const float lo = (w0 * bflo(a[j]) + w1 * bflo(bq[j]) + w2 * bflo(cq[j])) * bflo(gg[j]);
                const float hi = (w0 * bfhi(a[j]) + w1 * bfhi(bq[j]) + w2 * bfhi(cq[j])) * bfhi(gg[j]); o[j] = cvt_pk_bf16(lo, hi); }
            *(u32x4*)(GB + off + 8 * hh) = o;
        }
    }
}
DI void phase_final(const Params& p, int wave, int lane) {
    const int NW = gridDim.x * 8, gw = blockIdx.x * 8 + wave;
    float* h = p.out; const float* g = p.in[17];
    for (int row = gw; row < M; row += NW) {
        f32x4* xr = (f32x4*)(h + (size_t)row * 1024) + lane;
        f32x4 v[4]; float ss = 0.f;
#pragma unroll
        for (int j = 0; j < 4; ++j) { v[j] = xr[64 * j]; ss += (v[j][0] * v[j][0] + v[j][1] * v[j][1]) + (v[j][2] * v[j][2] + v[j][3] * v[j][3]); }
        const float rstd = 1.0f / sqrtf(wave_sum(ss) * (1.0f / 1024) + EPS);
#pragma unroll
        for (int j = 0; j < 4; ++j) xr[64 * j] = (v[j] * rstd) * *(const f32x4*)(g + 256 * j + 4 * lane);
    }
}

DI void grid_bar(unsigned* w, unsigned G, int wave) {
    __builtin_amdgcn_fence(__ATOMIC_RELEASE, "agent");
    asm volatile("s_waitcnt vmcnt(0) lgkmcnt(0)" ::: "memory");
    __syncthreads();
    if (wave == 0) {
        if (pg8::opaque_lane() == 0) {
            __hip_atomic_fetch_add(w, 1u, __ATOMIC_RELEASE, __HIP_MEMORY_SCOPE_AGENT);
            while (__hip_atomic_load(w, __ATOMIC_RELAXED, __HIP_MEMORY_SCOPE_AGENT) < G) __builtin_amdgcn_s_sleep(4);
        }
    }
    __syncthreads();
    __builtin_amdgcn_fence(__ATOMIC_ACQUIRE, "agent");
    asm volatile("s_waitcnt vmcnt(0) lgkmcnt(0)" ::: "memory");
}
extern __shared__ __attribute__((aligned(16))) unsigned char smem_raw[];

__global__ void __launch_bounds__(512) yoco_fwd(Params p, int ph_lo, int ph_hi) {
    cg::grid_group grid = cg::this_grid();
    LAS unsigned char* lds = (LAS unsigned char*)smem_raw;
    const int wave = __builtin_amdgcn_readfirstlane(threadIdx.x >> 6);
    unsigned char* ws = p.ws;
    pg8::StaticOrder S;
    const int G = gridDim.x, c = blockIdx.x;
    const float* modA = (const float*)(ws + OFF_MOD); const float* modB = modA + (size_t)NB * 3072;
    unsigned* bar = (unsigned*)(ws + OFF_BAR);
#define SEAM(k) if (ph_lo <= (k) && (k) < ph_hi - 1) { if ((k) == 0) grid.sync(); else grid_bar(bar + 64 * (k), (unsigned)G, wave); }
#ifndef PHASE_MASK
#define PHASE_MASK 0x3fff
#endif
#define RUN(k) if (((PHASE_MASK >> (k)) & 1) && ph_lo <= (k) && (k) < ph_hi)
    RUN(0) { const int lane = pg8::opaque_lane(); phase0(p, lds, wave * 64 + lane, wave, lane); }
    SEAM(0)
    RUN(1) { const int lane = pg8::opaque_lane(); phase_hnA(p, wave, lane); }
    SEAM(1)
    RUN(2) {
        { pg8::Gemm g{(const bf16_t*)p.out, (const bf16_t*)(ws + OFF_WA_MAIN), M, 4864, 1024, 2048, 1024, 0}; S.init(M, 4864, G, c);
          EpiAMain E{(bf16_t*)(ws + OFF_QCAT), (bf16_t*)(ws + OFF_GATE), (bf16_t*)(ws + OFF_KEYS), (float*)(ws + OFF_CKV), (const float*)(ws + OFF_ROPE_A)};
          pg8::gemm_phase<EpiAMain, pg8::StaticOrder, false>(lds, g, S, E, nullptr, wave); }
        { pg8::Gemm g{(const bf16_t*)p.out, (const bf16_t*)(ws + OFF_WA_IDX), M, 768, 3072, 2048, 2048, 0}; S.init(M, 768, G, c);
          EpiAIdx E{(bf16_t*)(ws + OFF_QIDX), (bf16_t*)(ws + OFF_KIDX), (float*)(ws + OFF_WIDX), (const float*)(ws + OFF_ROPE_I)};
          pg8::gemm_phase<EpiAIdx, pg8::StaticOrder, true>(lds, g, S, E, nullptr, wave); }
    }
    SEAM(2)
    RUN(3) { const int lane = pg8::opaque_lane(); phase_ckv(p, wave, lane); }
    SEAM(3)
    RUN(4) { const int lane = pg8::opaque_lane(); phase_dsa(p, lds, wave * 64 + lane, wave, lane); }
    SEAM(4)
    RUN(5) { pg8::Gemm g{(const bf16_t*)(ws + OFF_QCAT), (const bf16_t*)(ws + OFF_WUV), M, 2048, 256, 2560, 256, 256}; S.init(M, 2048, G, c);
        EpiUV E{(bf16_t*)(ws + OFF_GATE)}; pg8::gemm_phase<EpiUV, pg8::StaticOrder, false>(lds, g, S, E, nullptr, wave); }
    SEAM(5)
    RUN(6) { pg8::Gemm g{(const bf16_t*)(ws + OFF_GATE), (const bf16_t*)(ws + OFF_WAO), M, 1024, 2048, 2048, 2048, 0}; S.init(M, 1024, G, c);
        EpiRes E{p.in[0], p.out, modA + 2048}; pg8::gemm_phase<EpiRes, pg8::StaticOrder, false>(lds, g, S, E, nullptr, wave); }
    SEAM(6)
    RUN(7) { const int lane = pg8::opaque_lane(); phase_normB(p, wave, lane); }
    SEAM(7)
    RUN(8) { pg8::Gemm g{(const bf16_t*)(ws + OFF_HKV), (const bf16_t*)(ws + OFF_WKV), M, 2048, 1024, 1024, 1024, 0}; S.init(M, 2048, G, c);
        EpiKV E{(bf16_t*)(ws + OFF_KB), (bf16_t*)(ws + OFF_VB), (const float*)(ws + OFF_ROPE_B)}; pg8::gemm_phase<EpiKV, pg8::StaticOrder, false>(lds, g, S, E, nullptr, wave); }
    SEAM(8)
    RUN(9) { pg8::Gemm g{(const bf16_t*)(ws + OFF_HNB), (const bf16_t*)(ws + OFF_WBI), M, 4096, 1024, 1024, 1024, 0}; S.init(M, 4096, G, c);
        EpiBIn E{(bf16_t*)(ws + OFF_Q3), (bf16_t*)(ws + OFF_GB), (const float*)(ws + OFF_ROPE_B)}; pg8::gemm_phase<EpiBIn, pg8::StaticOrder, false>(lds, g, S, E, nullptr, wave); }
    SEAM(9)
    RUN(10) { const int lane = pg8::opaque_lane(); phase_dil(p, wave, lane); }
    SEAM(10)
    RUN(11) { const int lane = pg8::opaque_lane(); phase_merge(p, wave, lane); }
    SEAM(11)
    RUN(12) { pg8::Gemm g{(const bf16_t*)(ws + OFF_GB), (const bf16_t*)(ws + OFF_WBO), M, 1024, 1024, 1024, 1024, 0}; S.init(M, 1024, G, c);
        EpiRes E{p.out, p.out, modB + 2048}; pg8::gemm_phase<EpiRes, pg8::StaticOrder, false>(lds, g, S, E, nullptr, wave); }
    SEAM(12)
#if defined(DBG_HI) && DBG_NS > 0
    {
        grid_bar(bar + 64 * 15, (unsigned)G, wave);
        const bf16_t* src = (const bf16_t*)(ws + DBG_OFF); const int ld = DBG_LD;
        const int lane = pg8::opaque_lane();
        for (size_t i = (size_t)blockIdx.x * 512 + wave * 64 + lane; i < (size_t)M * 1024; i += (size_t)G * 512) {
            const size_t r = i >> 10, cc = i & 1023; float v = 0.f;
            for (int s = 0; s < DBG_NS; ++s) v += __uint_as_float((unsigned)src[r * ld + cc + 1024 * s] << 16);
            p.out[i] = v; }
    }
#endif
    RUN(13) { const int lane = pg8::opaque_lane(); phase_final(p, wave, lane); }
}

extern "C" void kernel_launch(void* const* d_in, const int* in_sizes, int n_in, void* d_out, int out_size, void* d_ws, size_t ws_size, hipStream_t stream) {
    static int grid_blocks = 0;
    if (grid_blocks == 0) {
        if (n_in != 18 || out_size != M * D || ws_size < WS_NEED) { fprintf(stderr, "kernel_launch: unexpected shapes (n_in %d out %d ws %zu need %zu)\n", n_in, out_size, ws_size, (size_t)WS_NEED); grid_blocks = -1; return; }
        int dev = 0, cus = 0, per_cu = 0;
        hipGetDevice(&dev); hipDeviceGetAttribute(&cus, hipDeviceAttributeMultiprocessorCount, dev);
        if (hipFuncSetAttribute((const void*)yoco_fwd, hipFuncAttributeMaxDynamicSharedMemorySize, LDS_BYTES) != hipSuccess) { fprintf(stderr, "kernel_launch: hipFuncSetAttribute failed\n"); grid_blocks = -1; return; }
        if (hipOccupancyMaxActiveBlocksPerMultiprocessor(&per_cu, (const void*)yoco_fwd, 512, LDS_BYTES) != hipSuccess || per_cu < 1) { fprintf(stderr, "kernel_launch: occupancy query gave %d\n", per_cu); per_cu = 1; }
        (void)hipGetLastError();
        grid_blocks = cus * per_cu; if (grid_blocks > MAX_GRID) grid_blocks = MAX_GRID;
    }
    if (grid_blocks < 0) return;
    if (hipMemsetAsync((char*)d_ws + OFF_BAR, 0, 16 * 256, stream) != hipSuccess) { fprintf(stderr, "kernel_launch: memset failed\n"); return; }
    Params p{};
    for (int i = 0; i < 18; ++i) p.in[i] = (const float*)d_in[i];
    p.out = (float*)d_out; p.ws = (unsigned char*)d_ws;
#ifdef DBG_HI
    int lo = 0, hi = DBG_HI;
#else
    int lo = 0, hi = 14;
#endif
    void* args[] = {&p, &lo, &hi};
    hipError_t e = hipLaunchCooperativeKernel((const void*)yoco_fwd, dim3(grid_blocks), dim3(512), args, LDS_BYTES, stream);
    if (e != hipSuccess) fprintf(stderr, "cooperative launch failed: %s (grid %d)\n", hipGetErrorString(e), grid_blocks);
}
```

```cpp
#include <hip/hip_runtime.h>
#include <hip/hip_cooperative_groups.h>
#include <cstdio>
#include <cstdint>
namespace cg = cooperative_groups;

namespace pg8 {
#define PG8_LAS __attribute__((address_space(3)))
typedef unsigned short bf16_t;
typedef short bf16x8 __attribute__((ext_vector_type(8)));
typedef float f32x4 __attribute__((ext_vector_type(4)));
typedef unsigned u32x4 __attribute__((ext_vector_type(4)));
constexpr int BM = 256, BK = 64, HALF = 128, HTB = HALF * BK * 2  , STAGE_BYTES = 8 * HTB, NXCD = 8, WGM = 4;

__host__ __device__ __forceinline__ int lds_byte(int r, int c) { const int st = (r >> 4) * 2 + (c >> 5), rr = r & 15, cc = c & 31, ob = rr * 64 + cc * 2; return st * 1024 + (ob ^ (((ob >> 9) & 1) << 5)); }
__host__ __device__ __forceinline__ void stage_rc(int b, int& R, int& C) { const int st = b / 1024, sb = b % 1024, swz = sb ^ (((sb >> 9) & 1) << 5); R = (st >> 1) * 16 + swz / 64; C = (st & 1) * 32 + (swz % 64) / 2; }
__host__ __device__ __forceinline__ int perm32(int rho) { const int n = rho >> 4, i = rho & 15; return 8 * (i >> 2) + 4 * n + (i & 3); }

struct Unit { int pm, pn; };
struct Gemm { const bf16_t* A; const bf16_t* Bt; int M, N, K, lda, ldb, aoff_pn, b1zero_pn; };

struct StaticOrder {
    int nM, nN, nwg, G, c;
    __host__ __device__ void init(int M, int N, int G_, int c_) { nM = M / BM; nN = N / BM; nwg = nM * nN; G = G_; c = c_; }
    __host__ __device__ bool next(int i, Unit& u) const {
        const long L = (long)i * G + c; if (L >= nwg) return false;
        int wgid = (int)L; { const int q = nwg / NXCD, r = nwg % NXCD, xcd = wgid % NXCD, off = wgid / NXCD; wgid = (xcd < r ? xcd * (q + 1) : r * (q + 1) + (xcd - r) * q) + off; }
        const int nig = WGM * nN, gid = wgid / nig, fm = gid * WGM, gsz = (nM - fm) < WGM ? (nM - fm) : WGM;
        u.pm = fm + ((wgid % nig) % gsz); u.pn = (wgid % nig) / gsz; return true;
    }
    __device__ __forceinline__ void a_ready(const Unit&) const {}
    __device__ __forceinline__ void done(const Unit&) const {}
};

struct RowOwnerOrder {
    int nN, c;
    __host__ __device__ void init(int, int N, int, int c_) { nN = N / BM; c = c_; }
    __host__ __device__ bool next(int i, Unit& u) const { if (i >= nN) return false; u.pm = c; u.pn = i; return true; }
    __device__ __forceinline__ void a_ready(const Unit&) const {}
    __device__ __forceinline__ void done(const Unit&) const {}
};
__device__ __forceinline__ int opaque_lane() { int l; asm volatile("v_mbcnt_lo_u32_b32 %0, -1, 0\n\tv_mbcnt_hi_u32_b32 %0, -1, %0" : "=v"(l)); return l; }
template <class Epi, class Sched, bool SPLIT = false, bool ALIGN_EPI = true, bool SP2 = true>
__device__ __forceinline__ void gemm_phase(PG8_LAS unsigned char* lds, const Gemm g, const Sched& S, const Epi& E, unsigned long long*, const int wave_in) {
    const int lane = opaque_lane(), wid = wave_in, tid = wid * 64 + lane, wr = wid >> 2, wc = wid & 3, fr = lane & 15, fq = lane >> 4;
    const int K = g.K, nt = SPLIT ? 48 : K / BK; const int lda = g.lda, ldb = g.ldb; (void)K;
    unsigned voffA[2], voffB[2];
#pragma unroll
    for (int i = 0; i < 2; ++i) { int R, C; stage_rc(tid * 16 + i * 8192, R, C); const int Rb = Epi::PERM ? ((R & ~31) + perm32(R & 31)) : R;
        voffA[i] = (unsigned)(R * lda + C) * 2u; voffB[i] = (unsigned)(Rb * ldb + C) * 2u; }
    const size_t kstep = (size_t)(BK * 2);
    const size_t hstepA = (size_t)HALF * lda * 2, hstepB = (size_t)HALF * ldb * 2;
    const size_t tstepA = 2 * hstepA, tstepB = 2 * hstepB, pnoffA = (size_t)g.aoff_pn * 2;
    const unsigned ldsw = (unsigned)wid * 1024u;
    const int aoff = lds_byte(wr * 64 + fr, fq * 8), boff = lds_byte(wc * 32 + fr, fq * 8);
#define PG8_SA(b, h) (((b) * 2 + (h)) * HTB)
#define PG8_SB(b, h) ((4 + (b) * 2 + (h)) * HTB)
#define PG8_STAGE(bufoff, gbase, voff) do { _Pragma("unroll") for (int _i = 0; _i < 2; ++_i) \
        __builtin_amdgcn_global_load_lds((const unsigned*)((const char*)(gbase) + (voff)[_i]), (PG8_LAS unsigned*)(lds + (bufoff) + ldsw + _i * 8192), 16, 0, 0); } while (0)
#define PG8_LDA(dst, b, h) do { _Pragma("unroll") for (int m = 0; m < 4; ++m) _Pragma("unroll") for (int k = 0; k < 2; ++k) dst[m][k] = *(const PG8_LAS bf16x8*)(lds + PG8_SA(b, h) + aoff + m * 2048 + k * 1024); } while (0)
#define PG8_LDB(dst, b, h) do { _Pragma("unroll") for (int n = 0; n < 2; ++n) _Pragma("unroll") for (int k = 0; k < 2; ++k) dst[n][k] = *(const PG8_LAS bf16x8*)(lds + PG8_SB(b, h) + boff + n * 2048 + k * 1024); } while (0)
#define PG8_MMA(ai, bj, At, Bt) do { __builtin_amdgcn_s_setprio(1); _Pragma("unroll") for (int m = 0; m < 4; ++m) _Pragma("unroll") for (int n = 0; n < 2; ++n) _Pragma("unroll") for (int k = 0; k < 2; ++k) \
        acc[ai][bj][m][n] = __builtin_amdgcn_mfma_f32_16x16x32_bf16(Bt[n][k], At[m][k], acc[ai][bj][m][n], 0, 0, 0); __builtin_amdgcn_s_setprio(0); } while (0)
#define PG8_WAIT_V(n) asm volatile("s_waitcnt vmcnt(" #n ")" ::: "memory")
#define PG8_WAIT_L(n) asm volatile("s_waitcnt lgkmcnt(" #n ")" ::: "memory")
#define PG8_BAR __builtin_amdgcn_s_barrier()
#define PG8_SCHED __builtin_amdgcn_sched_barrier(0)
#define KTA(t) (SPLIT ? ((t) < 32 ? (t) : (t) - 32) : (t))
#define KTB(t) (SPLIT ? ((t) < 16 ? (t) : (t) - 16) : (t))
    Unit cur, nxt; int ui = 0;
    if (!S.next(0, cur)) return;
    const bool bd = g.b1zero_pn == -2;
    bool b1z = g.b1zero_pn >= 0 && cur.pn == g.b1zero_pn;
    f32x4 acc[2][2][4][2];
#pragma unroll
    for (int a = 0; a < 2; ++a)
#pragma unroll
        for (int b = 0; b < 2; ++b)
#pragma unroll
            for (int m = 0; m < 4; ++m)
#pragma unroll
                for (int n = 0; n < 2; ++n) acc[a][b][m][n] = (f32x4){0.f, 0.f, 0.f, 0.f};
    bf16x8 At[4][2], B0[2][2], B1[2][2];
    const char* cA = (const char*)g.A + (size_t)cur.pm * tstepA + (size_t)cur.pn * pnoffA; const char* cB = (const char*)g.Bt + (size_t)cur.pn * tstepB;
    S.a_ready(cur);
    if constexpr (SP2) {
        PG8_STAGE(PG8_SB(0, 0), cB, voffB); PG8_STAGE(PG8_SB(0, 1), cB + hstepB, voffB); PG8_STAGE(PG8_SA(0, 0), cA, voffA); PG8_STAGE(PG8_SA(0, 1), cA + hstepA, voffA);
        if (wr == 1) PG8_BAR;
        PG8_WAIT_V(2); PG8_BAR;
        PG8_STAGE(PG8_SB(1, 0), cB + kstep, voffB); PG8_STAGE(PG8_SA(1, 0), cA + kstep, voffA); PG8_STAGE(PG8_SB(1, 1), cB + hstepB + kstep, voffB);
        PG8_WAIT_V(6); PG8_BAR;
    } else {
        PG8_STAGE(PG8_SB(0, 0), cB, voffB); PG8_STAGE(PG8_SA(0, 0), cA, voffA); PG8_STAGE(PG8_SB(0, 1), cB + hstepB, voffB); PG8_STAGE(PG8_SA(0, 1), cA + hstepA, voffA);
        if (wr == 1) PG8_BAR;
        PG8_WAIT_V(4); PG8_BAR;
        PG8_STAGE(PG8_SB(1, 0), cB + kstep, voffB); PG8_STAGE(PG8_SA(1, 0), cA + kstep, voffA); PG8_STAGE(PG8_SB(1, 1), cB + hstepB + kstep, voffB);
        PG8_WAIT_V(6); PG8_BAR;
    }
    for (;;) {
        const bool has_next = S.next(ui + 1, nxt);
        const char* nA = has_next ? (const char*)g.A + (size_t)nxt.pm * tstepA + (size_t)nxt.pn * pnoffA : cA; const char* nB = has_next ? (const char*)g.Bt + (size_t)nxt.pn * tstepB : cB;
#pragma unroll 1
        for (int t = 0; t < nt; t += 2) {
            const bool last = (t == nt - 2);
            const char* a1 = cA + (size_t)KTA(t + 1) * kstep;
            const char* a2 = last ? nA : cA + (size_t)KTA(t + 2) * kstep; const char* b2 = last ? nB : cB + (size_t)KTB(t + 2) * kstep;
            const char* a3 = a2 + kstep; const char* b3 = b2 + kstep;
            if (last && has_next) S.a_ready(nxt);
            if constexpr (SP2) {
            PG8_LDB(B0, 0, 0); PG8_LDB(B1, 0, 1); PG8_SCHED; PG8_LDA(At, 0, 0); PG8_STAGE(PG8_SA(1, 1), a1 + hstepA, voffA);
            PG8_WAIT_V(8); PG8_WAIT_L(0); PG8_BAR; if (!(bd && t >= 2)) PG8_MMA(0, 0, At, B0); if (!(b1z || (bd && t < 2))) PG8_MMA(0, 1, At, B1); PG8_BAR; PG8_SCHED;
            PG8_LDA(At, 0, 1); PG8_STAGE(PG8_SB(0, 0), b2, voffB); PG8_STAGE(PG8_SB(0, 1), b2 + hstepB, voffB); PG8_STAGE(PG8_SA(0, 0), a2, voffA);
            PG8_WAIT_V(8); PG8_WAIT_L(0); PG8_BAR; if (!(bd && t >= 2)) PG8_MMA(1, 0, At, B0); if (!(b1z || (bd && t < 2))) PG8_MMA(1, 1, At, B1); PG8_BAR; PG8_SCHED;
            PG8_LDB(B0, 1, 0); PG8_LDB(B1, 1, 1); PG8_SCHED; PG8_LDA(At, 1, 0); PG8_STAGE(PG8_SA(0, 1), a2 + hstepA, voffA);
            PG8_WAIT_V(8); PG8_WAIT_L(0); PG8_BAR; if (!(bd && t >= 2)) PG8_MMA(0, 0, At, B0); if (!(b1z || (bd && t < 2))) PG8_MMA(0, 1, At, B1); PG8_BAR; PG8_SCHED;
            PG8_LDA(At, 1, 1); PG8_STAGE(PG8_SB(1, 0), b3, voffB); PG8_STAGE(PG8_SB(1, 1), b3 + hstepB, voffB); PG8_STAGE(PG8_SA(1, 0), a3, voffA);
            PG8_WAIT_V(8); PG8_WAIT_L(0); PG8_BAR; if (!(bd && t >= 2)) PG8_MMA(1, 0, At, B0); if (!(b1z || (bd && t < 2))) PG8_MMA(1, 1, At, B1); PG8_BAR; PG8_SCHED;
            } else {
            PG8_LDB(B0, 0, 0); PG8_SCHED; PG8_LDA(At, 0, 0); PG8_STAGE(PG8_SA(1, 1), a1 + hstepA, voffA);
            PG8_WAIT_L(8); PG8_BAR; PG8_WAIT_L(0); PG8_MMA(0, 0, At, B0); PG8_BAR; PG8_SCHED;
            PG8_LDB(B1, 0, 1); PG8_STAGE(PG8_SB(0, 0), b2, voffB);
            PG8_BAR; PG8_WAIT_L(0); PG8_MMA(0, 1, At, B1); PG8_BAR;
            PG8_LDA(At, 0, 1); PG8_STAGE(PG8_SA(0, 0), a2, voffA);
            PG8_BAR; PG8_WAIT_L(0); PG8_MMA(1, 0, At, B0); PG8_BAR; PG8_SCHED;
            PG8_STAGE(PG8_SB(0, 1), b2 + hstepB, voffB);
            PG8_WAIT_V(6); PG8_BAR; PG8_MMA(1, 1, At, B1); PG8_BAR;
            PG8_LDB(B0, 1, 0); PG8_SCHED; PG8_LDA(At, 1, 0); PG8_STAGE(PG8_SA(0, 1), a2 + hstepA, voffA);
            PG8_WAIT_L(8); PG8_BAR; PG8_WAIT_L(0); PG8_MMA(0, 0, At, B0); PG8_BAR; PG8_SCHED;
            PG8_LDB(B1, 1, 1); PG8_STAGE(PG8_SB(1, 0), b3, voffB);
            PG8_BAR; PG8_WAIT_L(0); PG8_MMA(0, 1, At, B1); PG8_BAR;
            PG8_LDA(At, 1, 1); PG8_STAGE(PG8_SA(1, 0), a3, voffA);
            PG8_BAR; PG8_WAIT_L(0); PG8_MMA(1, 0, At, B0); PG8_BAR; PG8_SCHED;
            PG8_STAGE(PG8_SB(1, 1), b3 + hstepB, voffB);
            PG8_WAIT_V(6); PG8_BAR; PG8_MMA(1, 1, At, B1); PG8_BAR;
            }
        }
        if constexpr (ALIGN_EPI) { if (wr == 0) PG8_BAR; }
        if constexpr (!Epi::AFTER_DRAIN) { E(acc, cur, wr, wc, fr, fq); S.done(cur); }
        if (!has_next) break;
#pragma unroll
        for (int a = 0; a < 2; ++a)
#pragma unroll
            for (int b = 0; b < 2; ++b)
#pragma unroll
                for (int m = 0; m < 4; ++m)
#pragma unroll
                    for (int n = 0; n < 2; ++n) acc[a][b][m][n] = (f32x4){0.f, 0.f, 0.f, 0.f};
        cur = nxt; cA = nA; cB = nB; ++ui; b1z = g.b1zero_pn >= 0 && cur.pn == g.b1zero_pn;
        if constexpr (ALIGN_EPI) { if (wr == 1) PG8_BAR; }
    }
    PG8_WAIT_V(0);
    if constexpr (!ALIGN_EPI) { if (wr == 0) PG8_BAR; }
    PG8_BAR;
    if constexpr (Epi::AFTER_DRAIN) { E.fused(acc, cur, wr, wc, fr, fq, lds, wid, lane); S.done(cur); }
#undef PG8_SA
#undef PG8_SB
#undef PG8_STAGE
#undef PG8_LDA
#undef PG8_LDB
#undef PG8_MMA
#undef PG8_WAIT_V
#undef PG8_WAIT_L
#undef PG8_BAR
#undef PG8_SCHED
#undef KTA
#undef KTB
}
}

using pg8::bf16_t; using pg8::bf16x8; using pg8::f32x4; using pg8::u32x4; using pg8::Unit;
#define LAS __attribute__((address_space(3)))
#define DI __device__ __forceinline__
typedef float f32x16 __attribute__((ext_vector_type(16)));
typedef unsigned u32x2 __attribute__((ext_vector_type(2)));
typedef float f32x2 __attribute__((ext_vector_type(2)));
typedef short s16x4 __attribute__((ext_vector_type(4)));

constexpr int D = 1024, NB = 16, SEQ = 4096, M = NB * SEQ;
constexpr float EPS = 1e-6f;
constexpr size_t MBy = (size_t)1 << 20;
constexpr size_t OFF_WA_MAIN = 0, OFF_WA_IDX = 10 * MBy, OFF_WUV = 13 * MBy, OFF_WAO = 14 * MBy, OFF_WKV = 18 * MBy, OFF_WBI = 22 * MBy, OFF_WBO = 30 * MBy,
                 OFF_MOD = 32 * MBy, OFF_ROPE_A = 33 * MBy, OFF_ROPE_I = 41 * MBy, OFF_ROPE_B = 57 * MBy, OFF_ACT = 89 * MBy;
constexpr size_t OFF_QCAT = OFF_ACT, OFF_GATE = OFF_QCAT + 320 * MBy, OFF_QIDX = OFF_GATE + 256 * MBy, OFF_KEYS = OFF_QIDX + 128 * MBy, OFF_KIDX = OFF_KEYS + 20 * MBy,
                 OFF_WIDX = OFF_KIDX + 16 * MBy, OFF_CKV = OFF_WIDX + 2 * MBy, OFF_SC = OFF_CKV + 32 * MBy, END_A = OFF_SC + 128 * MBy;
constexpr size_t OFF_HNB = OFF_ACT, OFF_KB = OFF_HNB + 128 * MBy, OFF_VB = OFF_KB + 128 * MBy, OFF_Q3 = OFF_VB + 128 * MBy, OFF_GB = OFF_Q3 + 384 * MBy, OFF_HKV = OFF_GB,
                 OFF_LSE = OFF_GB + 128 * MBy, END_B = OFF_LSE + 6 * MBy;
constexpr size_t WS_NEED = END_A > END_B ? END_A : END_B;
constexpr size_t OFF_BAR = OFF_MOD + 768 * 1024;
constexpr int KROW = 160;
constexpr int LDS_BYTES = 152 * 1024;
constexpr int MAX_GRID = 256;

struct Params {
    const float* in[18];
    float* out; unsigned char* ws;
};

typedef __bf16 bf16x2_t __attribute__((ext_vector_type(2)));
DI unsigned cvt_pk_bf16(float lo, float hi) { const f32x2 f = {lo, hi}; const bf16x2_t v = __builtin_convertvector(f, bf16x2_t); return __builtin_bit_cast(unsigned, v); }
DI float bflo(unsigned w) { return __uint_as_float(w << 16); }
DI float bfhi(unsigned w) { return __uint_as_float(w & 0xffff0000u); }
DI float wave_sum(float v) {
#pragma unroll
    for (int o = 1; o < 64; o <<= 1) v += __shfl_xor(v, o);
    return v;
}
DI float silu_f(float x) { return x * (1.0f / (1.0f + __expf(-x))); }
DI u32x2 pack4(const f32x4& v) { u32x2 w; w.x = cvt_pk_bf16(v[0], v[1]); w.y = cvt_pk_bf16(v[2], v[3]); return w; }
DI f32x4 unpack4(const u32x2& w) { return (f32x4){bflo(w.x), bfhi(w.x), bflo(w.y), bfhi(w.y)}; }
#define WAVE_LDS_FENCE() asm volatile("s_waitcnt lgkmcnt(0)" ::: "memory")

DI float xrow_max(float x) {
    { const auto r = __builtin_amdgcn_permlane32_swap(__float_as_uint(x), __float_as_uint(x), false, false); x = fmaxf(__uint_as_float(r[0]), __uint_as_float(r[1])); }
    { const auto r = __builtin_amdgcn_permlane16_swap(__float_as_uint(x), __float_as_uint(x), false, false); x = fmaxf(__uint_as_float(r[0]), __uint_as_float(r[1])); }
    return x; }
DI float xrow_sum(float x) {
    { const auto r = __builtin_amdgcn_permlane32_swap(__float_as_uint(x), __float_as_uint(x), false, false); x = __uint_as_float(r[0]) + __uint_as_float(r[1]); }
    { const auto r = __builtin_amdgcn_permlane16_swap(__float_as_uint(x), __float_as_uint(x), false, false); x = __uint_as_float(r[0]) + __uint_as_float(r[1]); }
    return x; }
DI void rope4(const f32x4& x1, const f32x4& x2, const f32x4& t0, const f32x4& t1, float sc, f32x4& o1, f32x4& o2) {
    const f32x4 c = {t0[0], t0[2], t1[0], t1[2]}, s = {t0[1], t0[3], t1[1], t1[3]};
    o1 = (x1 * c - x2 * s) * sc; o2 = (x2 * c + x1 * s) * sc;
}
#define EPI_ROWS_BEGIN _Pragma("unroll") for (int ai = 0; ai < 2; ++ai) _Pragma("unroll") for (int m = 0; m < 4; ++m) { const int row = row0 + ai * 128 + m * 16;
#define EPI_ROWS_END }
#define ROPE_TABS(TAB, LD, FOFF) f32x4 t0_[4], t1_[4]; _Pragma("unroll") for (int m = 0; m < 4; ++m) { const float* tp_ = (TAB) + (unsigned)(row0 + ai * 128 + m * 16) * (unsigned)(LD) + (unsigned)(FOFF); t0_[m] = *(const f32x4*)tp_; t1_[m] = *(const f32x4*)(tp_ + 4); }

DI u32x4 pack8u(const f32x4& a, const f32x4& b) { u32x4 w; w.x = cvt_pk_bf16(a[0], a[1]); w.y = cvt_pk_bf16(a[2], a[3]); w.z = cvt_pk_bf16(b[0], b[1]); w.w = cvt_pk_bf16(b[2], b[3]); return w; }
struct EpiAMain {
    static constexpr bool PERM = true, AFTER_DRAIN = false;
    bf16_t* qcat; bf16_t* gate; bf16_t* keys; float* ckv; const float* ropeA; const float* gkv; LAS float* part;
    DI void operator()(const f32x4 (&acc)[2][2][4][2], const Unit& u, int wr, int wc, int fr, int fq) const {
        const int row0 = u.pm * 256 + wr * 64 + fr; const float qs = 0.07905694150420949f * 1.4426950408889634f;
        if (u.pn < 8) {
            EPI_ROWS_BEGIN
#pragma unroll
                for (int bj = 0; bj < 2; ++bj)
                    *(u32x4*)(qcat + (unsigned)row * 2560 + (2 * u.pn + bj) * 160 + 32 * wc + 8 * fq) = pack8u(acc[ai][bj][m][0] * qs, acc[ai][bj][m][1] * qs);
            EPI_ROWS_END
        } else if (u.pn < 10) {
#pragma unroll
            for (int ai = 0; ai < 2; ++ai) { ROPE_TABS(ropeA, 32, 8 * fq)
#pragma unroll
                for (int m = 0; m < 4; ++m) { const int row = row0 + ai * 128 + m * 16;
#pragma unroll
                    for (int bj = 0; bj < 2; ++bj) { f32x4 o1, o2; rope4(acc[ai][bj][m][0], acc[ai][bj][m][1], t0_[m], t1_[m], qs, o1, o2);
                        *(u32x4*)(qcat + (unsigned)row * 2560 + (8 * (u.pn - 8) + 4 * bj + wc) * 160 + 128 + 8 * fq) = pack8u(o1, o2); } } }
        } else if (u.pn < 18) {
            EPI_ROWS_BEGIN
#pragma unroll
                for (int bj = 0; bj < 2; ++bj) { f32x4 v0 = acc[ai][bj][m][0], v1 = acc[ai][bj][m][1];
#pragma unroll
                    for (int j = 0; j < 4; ++j) { v0[j] = silu_f(v0[j]); v1[j] = silu_f(v1[j]); }
                    *(u32x4*)(gate + (unsigned)row * 2048 + 256 * (u.pn - 10) + 128 * bj + 32 * wc + 8 * fq) = pack8u(v0, v1); }
            EPI_ROWS_END
        } else {
            const int rl0 = wr * 64 + fr;
#pragma unroll
            for (int ai = 0; ai < 2; ++ai)
#pragma unroll
                for (int m = 0; m < 4; ++m) { const f32x4 a0 = acc[ai][0][m][0], a1 = acc[ai][0][m][1];
                    const float t = xrow_sum(((a0[0] * a0[0] + a0[1] * a0[1]) + (a0[2] * a0[2] + a0[3] * a0[3])) + ((a1[0] * a1[0] + a1[1] * a1[1]) + (a1[2] * a1[2] + a1[3] * a1[3])));
                    if (fq == 0) part[(rl0 + ai * 128 + m * 16) * 4 + wc] = t; }
            asm volatile("s_waitcnt lgkmcnt(0)" ::: "memory"); __builtin_amdgcn_s_barrier(); asm volatile("" ::: "memory");
            const f32x4 g0 = *(const f32x4*)(gkv + 32 * wc + 8 * fq), g1 = *(const f32x4*)(gkv + 32 * wc + 8 * fq + 4);
#pragma unroll
            for (int ai = 0; ai < 2; ++ai) { ROPE_TABS(ropeA, 32, 8 * fq)
#pragma unroll
                for (int m = 0; m < 4; ++m) { const int row = row0 + ai * 128 + m * 16;
                    const f32x4 pq = *(const LAS f32x4*)(part + (rl0 + ai * 128 + m * 16) * 4);
                    const float rstd = 1.0f / sqrtf(((pq[0] + pq[1]) + (pq[2] + pq[3])) * (1.0f / 128) + EPS);
                    *(u32x4*)(keys + (unsigned)row * KROW + 32 * wc + 8 * fq) = pack8u(acc[ai][0][m][0] * rstd * g0, acc[ai][0][m][1] * rstd * g1);
                    if (wc == 0) { f32x4 o1, o2; rope4(acc[ai][1][m][0], acc[ai][1][m][1], t0_[m], t1_[m], 1.0f, o1, o2);
                        *(u32x4*)(keys + (unsigned)row * KROW + 128 + 8 * fq) = pack8u(o1, o2); } } }
        }
    }
};
DI void store_hilo8(bf16_t* dst, const f32x4& a, const f32x4& b) {
    const u32x4 h = pack8u(a, b); const f32x4 ra = a - (f32x4){bflo(h.x), bfhi(h.x), bflo(h.y), bfhi(h.y)}, rb = b - (f32x4){bflo(h.z), bfhi(h.z), bflo(h.w), bfhi(h.w)};
    *(u32x4*)dst = h; *(u32x4*)(dst + 64) = pack8u(ra, rb);
}
struct EpiAIdx {
    static constexpr bool PERM = true, AFTER_DRAIN = false;
    bf16_t* qidx; bf16_t* kidx; float* widx; const float* ropeI;
    DI void operator()(const f32x4 (&acc)[2][2][4][2], const Unit& u, int wr, int wc, int fr, int fq) const {
        const int row0 = u.pm * 256 + wr * 64 + fr; const int a = wc & 1;
#pragma unroll
        for (int ai = 0; ai < 2; ++ai) { ROPE_TABS(ropeI, 64, 2 * (16 * a + 4 * fq))
#pragma unroll
            for (int m = 0; m < 4; ++m) { const int row = row0 + ai * 128 + m * 16;
                if (u.pn < 2) {
#pragma unroll
                    for (int bj = 0; bj < 2; ++bj) { f32x4 o1, o2; rope4(acc[ai][bj][m][0], acc[ai][bj][m][1], t0_[m], t1_[m], 1.0f, o1, o2);
                        store_hilo8(qidx + (unsigned)row * 1024 + (4 * u.pn + 2 * bj + (wc >> 1)) * 128 + 32 * a + 8 * fq, o1, o2); }
                } else {
                    if (wc < 2) { f32x4 o1, o2; rope4(acc[ai][0][m][0], acc[ai][0][m][1], t0_[m], t1_[m], 1.0f, o1, o2);
                        store_hilo8(kidx + (unsigned)row * 128 + 32 * a + 8 * fq, o1, o2); }
                    if (wc == 2 && fq == 0) { *(f32x4*)(widx + (unsigned)row * 8) = acc[ai][0][m][0] * 0.35355339059327373f; *(f32x4*)(widx + (unsigned)row * 8 + 4) = acc[ai][0][m][1] * 0.35355339059327373f; }
                } } }
    }
};
struct EpiUV {
    static constexpr bool PERM = true, AFTER_DRAIN = false;
    bf16_t* gate;
    DI void operator()(const f32x4 (&acc)[2][2][4][2], const Unit& u, int wr, int wc, int fr, int fq) const {
        const int row0 = u.pm * 256 + wr * 64 + fr;
#pragma unroll
        for (int ai = 0; ai < 2; ++ai) {
            u32x4 gq[4][2];
#pragma unroll
            for (int m = 0; m < 4; ++m)
#pragma unroll
                for (int bj = 0; bj < 2; ++bj) gq[m][bj] = *(const u32x4*)(gate + (unsigned)(row0 + ai * 128 + m * 16) * 2048 + 256 * u.pn + 128 * bj + 32 * wc + 8 * fq);
#pragma unroll
            for (int m = 0; m < 4; ++m)
#pragma unroll
                for (int bj = 0; bj < 2; ++bj) { const u32x4 g = gq[m][bj];
                    *(u32x4*)(gate + (unsigned)(row0 + ai * 128 + m * 16) * 2048 + 256 * u.pn + 128 * bj + 32 * wc + 8 * fq) =
                        pack8u(acc[ai][bj][m][0] * (f32x4){bflo(g.x), bfhi(g.x), bflo(g.y), bfhi(g.y)}, acc[ai][bj][m][1] * (f32x4){bflo(g.z), bfhi(g.z), bflo(g.w), bfhi(g.w)}); }
        }
    }
};
struct EpiRes {
    static constexpr bool PERM = false, AFTER_DRAIN = false;
    const float* base; float* out; const float* mgate;
    DI void operator()(const f32x4 (&acc)[2][2][4][2], const Unit& u, int wr, int wc, int fr, int fq) const {
        const int row0 = u.pm * 256 + wr * 64 + fr; const float* mg = mgate + (size_t)(u.pm >> 4) * 3072;
#pragma unroll
        for (int bj = 0; bj < 2; ++bj) {
            f32x4 gv[2];
#pragma unroll
            for (int n = 0; n < 2; ++n) gv[n] = *(const f32x4*)(mg + 256 * u.pn + 128 * bj + 32 * wc + 16 * n + 4 * fq);
#pragma unroll
            for (int ai = 0; ai < 2; ++ai) {
                f32x4 bs[4][2];
#pragma unroll
                for (int m = 0; m < 4; ++m)
#pragma unroll
                    for (int n = 0; n < 2; ++n) bs[m][n] = *(const f32x4*)(base + (unsigned)(row0 + ai * 128 + m * 16) * 1024 + 256 * u.pn + 128 * bj + 32 * wc + 16 * n + 4 * fq);
#pragma unroll
                for (int m = 0; m < 4; ++m)
#pragma unroll
                    for (int n = 0; n < 2; ++n) *(f32x4*)(out + (unsigned)(row0 + ai * 128 + m * 16) * 1024 + 256 * u.pn + 128 * bj + 32 * wc + 16 * n + 4 * fq) = bs[m][n] + gv[n] * acc[ai][bj][m][n];
            }
        }
    }
};
struct EpiKV {
    static constexpr bool PERM = true, AFTER_DRAIN = false;
    bf16_t* kb; bf16_t* vb; const float* ropeB;
    DI void operator()(const f32x4 (&acc)[2][2][4][2], const Unit& u, int wr, int wc, int fr, int fq) const {
        const int row0 = u.pm * 256 + wr * 64 + fr;
        if (u.pn < 4) {
#pragma unroll
            for (int ai = 0; ai < 2; ++ai) { ROPE_TABS(ropeB, 128, 2 * (16 * wc + 4 * fq))
#pragma unroll
                for (int m = 0; m < 4; ++m) { const int row = row0 + ai * 128 + m * 16;
#pragma unroll
                    for (int bj = 0; bj < 2; ++bj) { f32x4 o1, o2; rope4(acc[ai][bj][m][0], acc[ai][bj][m][1], t0_[m], t1_[m], 1.0f, o1, o2);
                        *(u32x4*)(kb + (unsigned)row * 1024 + 256 * u.pn + 128 * bj + 32 * wc + 8 * fq) = pack8u(o1, o2); } } }
        } else {
            EPI_ROWS_BEGIN
#pragma unroll
                for (int bj = 0; bj < 2; ++bj)
                    *(u32x4*)(vb + (unsigned)row * 1024 + 256 * (u.pn - 4) + 128 * bj + 32 * wc + 8 * fq) = pack8u(acc[ai][bj][m][0], acc[ai][bj][m][1]);
            EPI_ROWS_END
        }
    }
};
struct EpiBIn {
    static constexpr bool PERM = true, AFTER_DRAIN = false;
    bf16_t* q3; bf16_t* gb; const float* ropeB;
    DI void operator()(const f32x4 (&acc)[2][2][4][2], const Unit& u, int wr, int wc, int fr, int fq) const {
        const int row0 = u.pm * 256 + wr * 64 + fr;
        if (u.pn < 12) {
            bf16_t* qg = q3 + (size_t)(u.pn >> 2) * M * 1024;
#pragma unroll
            for (int ai = 0; ai < 2; ++ai) { ROPE_TABS(ropeB, 128, 2 * (16 * wc + 4 * fq))
#pragma unroll
                for (int m = 0; m < 4; ++m) { const int row = row0 + ai * 128 + m * 16;
#pragma unroll
                    for (int bj = 0; bj < 2; ++bj) { f32x4 o1, o2; rope4(acc[ai][bj][m][0], acc[ai][bj][m][1], t0_[m], t1_[m], 0.08838834764831845f, o1, o2);
                        *(u32x4*)(qg + (unsigned)row * 1024 + 256 * (u.pn & 3) + 128 * bj + 32 * wc + 8 * fq) = pack8u(o1, o2); } } }
        } else {
            EPI_ROWS_BEGIN
#pragma unroll
                for (int bj = 0; bj < 2; ++bj)
                { f32x4 v0 = acc[ai][bj][m][0], v1 = acc[ai][bj][m][1];
#pragma unroll
                    for (int j = 0; j < 4; ++j) { v0[j] = silu_f(v0[j]); v1[j] = silu_f(v1[j]); }
                    *(u32x4*)(gb + (unsigned)row * 1024 + 256 * (u.pn - 12) + 128 * bj + 32 * wc + 8 * fq) = pack8u(v0, v1); }
            EPI_ROWS_END
        }
    }
};

DI int map_src_col(int mat, int n) {
    switch (mat) {
    case 0:
        if (n < 2048) return n;
        if (n < 2560) { const int p = n & 31; return (n & ~31) + 16 * ((p >> 2) & 1) + 4 * (p >> 3) + (p & 3); }
        if (n < 4608) return 2720 + (n - 2560);
        if (n < 4736) return 2560 + (n - 4608);
        if (n < 4768) { const int p = n - 4736; return 2688 + 16 * ((p >> 2) & 1) + 4 * (p >> 3) + (p & 3); }
        return -1;
    case 1:
        if (n < 576) { const int hd = n >> 6, p = n & 63, a = p >> 5, fq = (p >> 3) & 3, nn = (p >> 2) & 1, j = p & 3; return 4768 + hd * 64 + nn * 32 + a * 16 + 4 * fq + j; }
        if (n < 584) return 5344 + (n - 576);
        return -1;
    case 3: case 4: {
        const int lim = (mat == 3) ? 1024 : 3072;
        if (n < lim) { const int hd = n >> 7, p = n & 127, a = p >> 5, fq = (p >> 3) & 3, nn = (p >> 2) & 1, j = p & 3; return hd * 128 + nn * 64 + a * 16 + 4 * fq + j; }
        return n; }
    default: return n;
    }
}
DI void transpose_tile(const float* W, int ldw, int k0, int srccol, bf16_t* dst  , int ldk, bool split, LAS float* scr, int lane) {
#pragma unroll 8
    for (int i = 0; i < 32; ++i) { const int kk = 2 * i + (lane >> 5); scr[kk * 33 + (lane & 31)] = srccol >= 0 ? W[(size_t)(k0 + kk) * ldw + srccol] : 0.0f; }
    WAVE_LDS_FENCE();
    const int c = lane & 7;
#pragma unroll
    for (int j = 0; j < 4; ++j) { const int n = (lane >> 3) + 8 * j; const LAS float* s = scr + (8 * c) * 33 + n;
        float v[8];
#pragma unroll
        for (int e = 0; e < 8; ++e) v[e] = s[e * 33];
        u32x4 h; h.x = cvt_pk_bf16(v[0], v[1]); h.y = cvt_pk_bf16(v[2], v[3]); h.z = cvt_pk_bf16(v[4], v[5]); h.w = cvt_pk_bf16(v[6], v[7]);
        *(u32x4*)(dst + (size_t)n * ldk + 8 * c) = h;
        if (split) { u32x4 l; l.x = cvt_pk_bf16(v[0] - bflo(h.x), v[1] - bfhi(h.x)); l.y = cvt_pk_bf16(v[2] - bflo(h.y), v[3] - bfhi(h.y));
            l.z = cvt_pk_bf16(v[4] - bflo(h.z), v[5] - bfhi(h.z)); l.w = cvt_pk_bf16(v[6] - bflo(h.w), v[7] - bfhi(h.w));
            *(u32x4*)(dst + (size_t)n * ldk + 1024 + 8 * c) = l; } }
    WAVE_LDS_FENCE();
}
DI double ipow(double base, int e) { double r = 1.0, b = base; for (int i = 0; i < 6; ++i) { if (e & 1) r *= b; b *= b; e >>= 1; } return r; }
DI void phase0(const Params& p, LAS unsigned char* lds, int tid, int wave, int lane) {
    unsigned char* ws = p.ws;
    const int G = gridDim.x, NW = G * 8, gw = wave * G + blockIdx.x;
    LAS float* sc = (LAS float*)lds;
    LAS float* scr = (LAS float*)(lds + 65536 + wave * 8448);
    {
        for (int i = tid; i < NB * D; i += 512) { const int b = i >> 10, k = i & 1023; sc[k * 16 + b] = silu_f(p.in[1][i]); }
        __syncthreads();
    }
    constexpr int I_MOD = 384, I0 = 16 * 152, I1 = 16 * 24, I2 = 32 * 32, I3 = 16 * 64, I4 = 16 * 128, I5 = 16 * 32, I6 = 128;
    constexpr int NITEMS = I_MOD + I0 + I1 + I2 + I3 + I4 + I5 + I6;
    for (int it = gw; it < NITEMS; it += NW) {
        int r = it;
        if (r < I_MOD) {
            const int layer = r / 192, cgp = r % 192, col = cgp * 16 + (lane & 15), kp = lane >> 4;
            const float* Wm = p.in[layer ? 13 : 4]; const float* bias = p.in[layer ? 14 : 5];
            float acc[16];
#pragma unroll
            for (int b = 0; b < 16; ++b) acc[b] = 0.f;
#pragma unroll 8
            for (int k = kp * 256; k < kp * 256 + 256; ++k) { const float w = Wm[(size_t)k * 3072 + col];
                const f32x4 s0 = *(const LAS f32x4*)(sc + k * 16), s1 = *(const LAS f32x4*)(sc + k * 16 + 4), s2 = *(const LAS f32x4*)(sc + k * 16 + 8), s3 = *(const LAS f32x4*)(sc + k * 16 + 12);
#pragma unroll
                for (int j = 0; j < 4; ++j) { acc[j] += s0[j] * w; acc[4 + j] += s1[j] * w; acc[8 + j] += s2[j] * w; acc[12 + j] += s3[j] * w; } }
#pragma unroll
            for (int b = 0; b < 16; ++b) { acc[b] += __shfl_xor(acc[b], 16); acc[b] += __shfl_xor(acc[b], 32); }
            if (kp == 0) { float* mod = (float*)(ws + OFF_MOD) + (size_t)layer * NB * 3072; const float bv = bias[col];
#pragma unroll
                for (int b = 0; b < 16; ++b) mod[b * 3072 + col] = acc[b] + bv; }
            continue;
        }
        r -= I_MOD;
        int mat, K, ldw, ldk; const float* W; bf16_t* WT; bool split = false;
        if (r < I0) { mat = 0; W = p.in[6]; ldw = 5352; K = 1024; ldk = 1024; WT = (bf16_t*)(ws + OFF_WA_MAIN); }
        else if ((r -= I0) < I1) { mat = 1; W = p.in[6]; ldw = 5352; K = 1024; ldk = 2048; WT = (bf16_t*)(ws + OFF_WA_IDX); split = true; }
        else if ((r -= I1) < I2) { mat = 2; W = p.in[9]; ldw = 1024; K = 2048; ldk = 2048; WT = (bf16_t*)(ws + OFF_WAO); }
        else if ((r -= I2) < I3) { mat = 3; W = p.in[11]; ldw = 2048; K = 1024; ldk = 1024; WT = (bf16_t*)(ws + OFF_WKV); }
        else if ((r -= I3) < I4) { mat = 4; W = p.in[15]; ldw = 4096; K = 1024; ldk = 1024; WT = (bf16_t*)(ws + OFF_WBI); }
        else if ((r -= I4) < I5) { mat = 5; W = p.in[16]; ldw = 1024; K = 1024; ldk = 1024; WT = (bf16_t*)(ws + OFF_WBO); }
        else { r -= I5; mat = 6; W = nullptr; ldw = 128; K = 128; ldk = 256; WT = (bf16_t*)(ws + OFF_WUV); }
        if (mat < 6) {
            const int nkb = K / 64, kb = r % nkb, nb = r / nkb, n0 = nb * 32, k0 = kb * 64;
            const int srccol = map_src_col(mat, n0 + (lane & 31));
            transpose_tile(W, ldw, k0, srccol, WT + (size_t)n0 * ldk + k0, ldk, split, scr, lane);
        } else {
            const int h = r >> 3, cb = (r >> 2) & 1, vb = r & 3;
            bf16_t* dst = WT + (size_t)(h * 128 + vb * 32) * 256 + (h & 1) * 128 + cb * 64;
            transpose_tile(p.in[8] + (size_t)h * 16384, 128, cb * 64, vb * 32 + (lane & 31), dst, 256, false, scr, lane);
            bf16_t* dz = WT + (size_t)(h * 128 + vb * 32) * 256 + (1 - (h & 1)) * 128 + cb * 64;
            const int c = lane & 7;
#pragma unroll
            for (int j = 0; j < 4; ++j) { const int n = (lane >> 3) + 8 * j; *(u32x4*)(dz + (size_t)n * 256 + 8 * c) = (u32x4){0u, 0u, 0u, 0u}; }
        }
    }
    const int* pos = (const int*)p.in[2];
    for (size_t idx = (size_t)blockIdx.x * 512 + tid; idx < (size_t)M * 112; idx += (size_t)G * 512) {
        const int tok = (int)(idx / 112), e = (int)(idx % 112);
        double base; int f; float* dst;
        if (e < 16) { base = 0.5623413251903491; f = e; dst = (float*)(ws + OFF_ROPE_A) + ((size_t)tok * 16 + f) * 2; }
        else if (e < 48) { base = 0.7498942093324559; f = e - 16; dst = (float*)(ws + OFF_ROPE_I) + ((size_t)tok * 32 + f) * 2; }
        else { base = 0.8659643233600653; f = e - 48; dst = (float*)(ws + OFF_ROPE_B) + ((size_t)tok * 64 + f) * 2; }
        const double ang = (double)pos[tok] * ipow(base, f);
        const double kq = __builtin_rint(ang * 0.6366197723675814);
        double rr = __builtin_fma(-kq, 1.5707963267948966, ang); rr = __builtin_fma(-kq, 6.123233995736766e-17, rr);
        const double r2 = rr * rr;
        double sn = rr * (1.0 + r2 * (-1.0 / 6 + r2 * (1.0 / 120 + r2 * (-1.0 / 5040 + r2 * (1.0 / 362880 + r2 * (-1.0 / 39916800 + r2 * (1.0 / 6227020800.0)))))));
        double cs = 1.0 + r2 * (-0.5 + r2 * (1.0 / 24 + r2 * (-1.0 / 720 + r2 * (1.0 / 40320 + r2 * (-1.0 / 3628800 + r2 * (1.0 / 479001600.0 + r2 * (-1.0 / 87178291200.0)))))));
        const int q = (int)((long long)kq & 3);
        double co, si;
        if (q == 0) { co = cs; si = sn; } else if (q == 1) { co = -sn; si = cs; } else if (q == 2) { co = -cs; si = -sn; } else { co = sn; si = -cs; }
        *(f32x2*)dst = (f32x2){(float)co, (float)si};
    }
}

DI float row_ss(const f32x4 (&v)[4]) { float ss = 0.f;
#pragma unroll
    for (int j = 0; j < 4; ++j) ss += (v[j][0] * v[j][0] + v[j][1] * v[j][1]) + (v[j][2] * v[j][2] + v[j][3] * v[j][3]);
    return ss; }
DI void phase_hnA(const Params& p, int wave, int lane) {
    const int NW = gridDim.x * 8, gw = blockIdx.x * 8 + wave;
    const float* x = p.in[0]; const float* g = p.in[3]; const float* mod = (const float*)(p.ws + OFF_MOD);
    bf16_t* HN = (bf16_t*)p.out;
#pragma unroll 1
    for (int row0 = gw * 4; row0 < M; row0 += NW * 4) {
        const int b = row0 >> 12;
        f32x4 v[4][4]; float rstd[4];
#pragma unroll
        for (int r = 0; r < 4; ++r)
#pragma unroll
            for (int j = 0; j < 4; ++j) v[r][j] = *((const f32x4*)(x + (size_t)(row0 + r) * 1024) + lane + 64 * j);
#pragma unroll
        for (int r = 0; r < 4; ++r) rstd[r] = 1.0f / sqrtf(wave_sum(row_ss(v[r])) * (1.0f / 1024) + EPS);
#pragma unroll
        for (int j = 0; j < 4; ++j) { const int col = 256 * j + 4 * lane;
            const f32x4 gv = *(const f32x4*)(g + col), sh = *(const f32x4*)(mod + (size_t)b * 3072 + col), scv = *(const f32x4*)(mod + (size_t)b * 3072 + 1024 + col);
            const f32x4 gs = gv * (scv + 1.0f);
#pragma unroll
            for (int r = 0; r < 4; ++r) { const f32x4 y = (v[r][j] * rstd[r]) * gs + sh;
                const u32x2 h = pack4(y); const f32x4 rem = y - unpack4(h);
                *(u32x2*)(HN + (size_t)(row0 + r) * 2048 + col) = h; *(u32x2*)(HN + (size_t)(row0 + r) * 2048 + 1024 + col) = pack4(rem); } }
    }
}
DI void phase_ckv(const Params& p, int wave, int lane) {
    const int NW = gridDim.x * 8, gw = blockIdx.x * 8 + wave;
    const float* ckv = (const float*)(p.ws + OFF_CKV); bf16_t* keys = (bf16_t*)(p.ws + OFF_KEYS); const float* g = p.in[7];
    const f32x2 gv = *(const f32x2*)(g + 2 * lane);
    for (int row = gw; row < M; row += NW) {
        const f32x2 v = *(const f32x2*)(ckv + (size_t)row * 128 + 2 * lane);
        const float rstd = 1.0f / sqrtf(wave_sum(v[0] * v[0] + v[1] * v[1]) * (1.0f / 128) + EPS);
        *(unsigned*)(keys + (size_t)row * KROW + 2 * lane) = cvt_pk_bf16(v[0] * rstd * gv[0], v[1] * rstd * gv[1]);
    }
}

#define MFMA32(a, b, c) __builtin_amdgcn_mfma_f32_32x32x16_bf16((a), (b), (c), 0, 0, 0)
#define MFMA16(a, b, c) __builtin_amdgcn_mfma_f32_16x16x32_bf16((a), (b), (c), 0, 0, 0)
DI bf16x8 pack8(const f32x4& a, const f32x4& b) { u32x4 w; w.x = cvt_pk_bf16(a[0], a[1]); w.y = cvt_pk_bf16(a[2], a[3]); w.z = cvt_pk_bf16(b[0], b[1]); w.w = cvt_pk_bf16(b[2], b[3]); return __builtin_bit_cast(bf16x8, w); }
DI bf16x8 ident_frag(int lane, int half) {
    const int n = lane & 15, g = lane >> 4; u32x4 w = {0u, 0u, 0u, 0u};
    if (g == 2 * half + (n >> 3)) { const int jj = n & 7; const unsigned one = (jj & 1) ? 0x3F800000u : 0x00003F80u;
        if ((jj >> 1) == 0) w.x = one; else if ((jj >> 1) == 1) w.y = one; else if ((jj >> 1) == 2) w.z = one; else w.w = one; }
    return __builtin_bit_cast(bf16x8, w);
}
DI unsigned mbcnt64(unsigned long long m) { return __builtin_amdgcn_mbcnt_hi((unsigned)(m >> 32), __builtin_amdgcn_mbcnt_lo((unsigned)m, 0u)); }


DI int wave_sum_dpp(int v) {
    v += __builtin_amdgcn_update_dpp(0, v, 0x111, 0xf, 0xf, true);
    v += __builtin_amdgcn_update_dpp(0, v, 0x112, 0xf, 0xf, true);
    v += __builtin_amdgcn_update_dpp(0, v, 0x114, 0xf, 0xf, true);
    v += __builtin_amdgcn_update_dpp(0, v, 0x118, 0xf, 0xf, true);
    v += __builtin_amdgcn_update_dpp(0, v, 0x142, 0xa, 0xf, false);
    v += __builtin_amdgcn_update_dpp(0, v, 0x143, 0xc, 0xf, false);
    return __builtin_amdgcn_readlane(v, 63);
}
template <int J>
DI void dsa_select(const float* scq, const int N, const int lv, LAS int* sel) {
    unsigned u[J];
#pragma unroll
    for (int j = 0; j < J; ++j) { unsigned bits = __float_as_uint(__hip_atomic_load(scq + j * 64 + lv, __ATOMIC_RELAXED, __HIP_MEMORY_SCOPE_AGENT)); if (bits == 0x80000000u) bits = 0u;
        const unsigned o = bits ^ ((bits >> 31) ? 0xFFFFFFFFu : 0x80000000u); u[j] = (lv < N - j * 64) ? o : 0u; }
    unsigned T = 0u; int A = J * 64, B = 0; int bit = 31;
#pragma unroll 1
    for (; bit >= 0; --bit) {
        if (A - B <= 64 && bit < 31) break;
        const unsigned cand = T | (1u << bit); int cl = 0;
#pragma unroll
        for (int j = 0; j < J; ++j) cl += (u[j] >= cand) ? 1 : 0;
        const int C = wave_sum_dpp(cl);
        if (C >= 256) { T = cand; A = C; } else B = C;
    }
    if (bit >= 0) {
        const int sh = bit + 1; int nb = 0;
#pragma unroll
        for (int j = 0; j < J; ++j) { const bool und = ((u[j] ^ T) >> sh) == 0u; const unsigned long long um = __ballot(und);
            const int slot = (int)__builtin_amdgcn_mbcnt_hi((unsigned)(um >> 32), __builtin_amdgcn_mbcnt_lo((unsigned)um, (unsigned)nb));
            sel[und ? slot : 256 + lv] = (int)u[j]; nb += __popcll(um); }
        WAVE_LDS_FENCE();
        const unsigned w = (lv < nb) ? (unsigned)sel[lv] : 0u;
        WAVE_LDS_FENCE();
        const int B0 = B;
#pragma unroll 1
        for (; bit >= 0; --bit) { const unsigned cand = T | (1u << bit); const int C = B0 + __popcll(__ballot(w >= cand)); if (C >= 256) T = cand; else B = C; }
    }
    int base = 0;
#pragma unroll
    for (int j = 0; j < J; ++j) { const bool gt = u[j] > T; const unsigned long long gm = __ballot(gt);
        const int slot = (int)__builtin_amdgcn_mbcnt_hi((unsigned)(gm >> 32), __builtin_amdgcn_mbcnt_lo((unsigned)gm, (unsigned)base));
        sel[gt ? slot : 256 + lv] = j * 64 + lv; base += __popcll(gm); }
    int remaining = 256 - base;
#pragma unroll
    for (int j = 0; j < J; ++j) { const bool eq = u[j] == T; const unsigned long long em = __ballot(eq);
        if (em != 0ull && remaining > 0) { const int r = (int)mbcnt64(em); if (eq && r < remaining) sel[base + r] = j * 64 + lv;
            const int c = __popcll(em), tk = c < remaining ? c : remaining; base += tk; remaining -= tk; } }
}
DI void phase_dsa(const Params& p, LAS unsigned char* lds, int tid, int wave, int lane) {
    unsigned char* ws = p.ws;
    const bf16_t* QIDX = (const bf16_t*)(ws + OFF_QIDX); const bf16_t* KIDX = (const bf16_t*)(ws + OFF_KIDX); const float* WIDX = (const float*)(ws + OFF_WIDX);
    bf16_t* QCAT = (bf16_t*)(ws + OFF_QCAT); const bf16_t* KEYS = (const bf16_t*)(ws + OFF_KEYS);
    float* SC = (float*)(ws + OFF_SC) + (size_t)blockIdx.x * (32 * 4096);
    LAS unsigned char* Qs = lds; LAS int* sel = (LAS int*)(lds + 66048 + wave * 2048);
    const int G = gridDim.x;
#ifdef PROBE
    if (wave == 0 && lane == 0) { ((LAS unsigned*)(lds + 150000))[0] = 0u; ((LAS unsigned*)(lds + 150000))[1] = 0u; }
#endif
    const bf16x8 e0 = ident_frag(lane, 0), e1 = ident_frag(lane, 1);
    const float NEG_INF = -__builtin_huge_valf();
    for (int rd = 0;; ++rd) {
        int t;
        if (G == 256) {
            if (rd >= 8) break;
            const int j = (int)blockIdx.x >> 3, r4 = rd & 3, tt = r4 * 32 + ((r4 & 1) ? (31 - j) : j);
            t = (tt << 4) + ((int)blockIdx.x & 7) + 8 * (rd >> 2);
        } else { t = rd * G + ((rd & 1) ? (G - 1 - (int)blockIdx.x) : (int)blockIdx.x); if (t >= 2048) break; }
        int lo_ = lane; asm volatile("" : "+v"(lo_)); const int l31 = lo_ & 31, h2 = lo_ >> 5;
        const int qt = 127 - (t >> 4), b = t & 15, q0 = qt * 32; const size_t tok0 = (size_t)b * SEQ;
        int tid_ = tid; asm volatile("" : "+v"(tid_));
        for (int idx = tid_; idx < 32 * 128; idx += 512) { const int q = idx >> 7, ch = idx & 127;
            *(LAS u32x4*)(Qs + q * 2064 + ch * 16) = *(const u32x4*)(QIDX + (tok0 + q0 + q) * 1024 + ch * 8); }
        float wq[8];
        { const f32x4 w0 = *(const f32x4*)(WIDX + (tok0 + q0 + l31) * 8), w1 = *(const f32x4*)(WIDX + (tok0 + q0 + l31) * 8 + 4);
#pragma unroll
          for (int j = 0; j < 4; ++j) { wq[j] = w0[j]; wq[4 + j] = w1[j]; } }
        __syncthreads();
#ifndef DSA_NOSCORE
#ifdef DSA_REP_SCORE
        for (int rep_ = 0; rep_ < 2; ++rep_)
#endif
        for (int kt = wave; kt <= qt; kt += 8) {
            const bf16_t* kp = KIDX + (tok0 + kt * 32 + l31) * 128 + 8 * h2;
            bf16x8 Ah[4], Al[4];
#pragma unroll
            for (int kc = 0; kc < 4; ++kc) { Ah[kc] = *(const bf16x8*)(kp + 16 * kc); Al[kc] = *(const bf16x8*)(kp + 64 + 16 * kc); }
            f32x16 s;
#pragma unroll
            for (int i = 0; i < 16; ++i) s[i] = 0.f;
#pragma unroll
            for (int h = 0; h < 8; ++h) {
                f32x16 acc;
#pragma unroll
                for (int i = 0; i < 16; ++i) acc[i] = 0.f;
#pragma unroll
                for (int kc = 0; kc < 4; ++kc) {
                    const bf16x8 Bh = *(const LAS bf16x8*)(Qs + l31 * 2064 + h * 256 + (16 * kc + 8 * h2) * 2);
                    const bf16x8 Bl = *(const LAS bf16x8*)(Qs + l31 * 2064 + h * 256 + 128 + (16 * kc + 8 * h2) * 2);
                    acc = MFMA32(Ah[kc], Bh, acc); acc = MFMA32(Al[kc], Bh, acc); acc = MFMA32(Ah[kc], Bl, acc);
                }
#pragma unroll
                for (int i = 0; i < 16; ++i) s[i] += wq[h] * fmaxf(acc[i], 0.f);
                asm volatile("" ::: "memory");
            }
            float* dst = SC + (size_t)l31 * 4096 + kt * 32 + 4 * h2;
#pragma unroll
            for (int jj = 0; jj < 4; ++jj) *(f32x4*)(dst + 8 * jj) = (f32x4){s[4 * jj], s[4 * jj + 1], s[4 * jj + 2], s[4 * jj + 3]};
        }
#endif
        asm volatile("s_waitcnt vmcnt(0)" ::: "memory");
        __syncthreads();
#ifdef PROBE
        unsigned long long pt0_ = __builtin_amdgcn_s_memrealtime();
#endif
#pragma unroll 1
        for (int qi = 0; qi < 4; ++qi) {
            const int ql = wave * 4 + qi, spos = q0 + ql, N = spos + 1; const size_t tok = tok0 + spos;
            int lv = lane; asm volatile("" : "+v"(lv)); const int ln = lv & 15, g4 = lv >> 4;
            int nvalid;
            if (N <= 256) {
                nvalid = N;
#pragma unroll
                for (int j = 0; j < 4; ++j) { const int k = j * 64 + lv; sel[k] = k < N ? k : 0; }
            } else {
                nvalid = 256;
#ifndef DSA_NOSEL
                const float* scq = SC + (size_t)ql * 4096;
                if (N <= 1024) dsa_select<16>(scq, N, lv, sel);
                else if (N <= 2048) dsa_select<32>(scq, N, lv, sel);
                else if (N <= 3072) dsa_select<48>(scq, N, lv, sel);
                else dsa_select<64>(scq, N, lv, sel);
#endif
            }
            WAVE_LDS_FENCE();
#ifdef PROBE
            { const unsigned long long t1_ = __builtin_amdgcn_s_memrealtime(); if (blockIdx.x == PROBE_BLK && wave == 0 && lane == 0) ((LAS unsigned*)(lds + 150000))[0] += (unsigned)(t1_ - pt0_); pt0_ = t1_; }
#endif
#ifdef DBG_DSA
            { float* dbg = p.out + tok * 1024;
#pragma unroll
              for (int j = 0; j < 4; ++j) dbg[j * 64 + lv] = (float)sel[j * 64 + lv];
              dbg[256 + lv] = (float)nvalid; }
#define DSA_NOATTN
#endif
#ifndef DSA_NOATTN
#ifndef DSA_REP_ATTN
#define DSA_REP_ATTN 1
#endif
#pragma unroll 1
            for (int rep_ = 0; rep_ < DSA_REP_ATTN; ++rep_) {
            const bf16_t* qp = QCAT + tok * 2560 + ln * 160 + 8 * g4;
            bf16x8 qf[5];
#pragma unroll
            for (int kc = 0; kc < 5; ++kc) qf[kc] = *(const bf16x8*)(qp + 32 * kc);
            const int npair = (nvalid + 31) >> 5;
            float m_run = NEG_INF, l_run = 0.f;
            f32x4 O[8];
#pragma unroll
            for (int d = 0; d < 8; ++d) O[d] = (f32x4){0.f, 0.f, 0.f, 0.f};
            bf16x8 f0[5], f1[5], n0[5], n1[5];
            { const bf16_t* kp0 = KEYS + (tok0 + sel[ln]) * KROW + 8 * g4; const bf16_t* kp1 = KEYS + (tok0 + sel[16 + ln]) * KROW + 8 * g4;
#pragma unroll
              for (int kc = 0; kc < 5; ++kc) { f0[kc] = *(const bf16x8*)(kp0 + 32 * kc); f1[kc] = *(const bf16x8*)(kp1 + 32 * kc); } }
            auto pair_body = [&](const bf16x8 (&c0)[5], const bf16x8 (&c1)[5], bf16x8 (&x0)[5], bf16x8 (&x1)[5], const int up) __attribute__((always_inline)) {
                if (up + 1 < npair) {
                    const bf16_t* kp0 = KEYS + (tok0 + sel[32 * up + 32 + ln]) * KROW + 8 * g4; const bf16_t* kp1 = KEYS + (tok0 + sel[32 * up + 48 + ln]) * KROW + 8 * g4;
#pragma unroll
                    for (int kc = 0; kc < 5; ++kc) { x0[kc] = *(const bf16x8*)(kp0 + 32 * kc); x1[kc] = *(const bf16x8*)(kp1 + 32 * kc); }
                }
                f32x4 s0 = {0.f, 0.f, 0.f, 0.f}, s1 = {0.f, 0.f, 0.f, 0.f};
#pragma unroll
                for (int kc = 0; kc < 5; ++kc) { s0 = MFMA16(c0[kc], qf[kc], s0); s1 = MFMA16(c1[kc], qf[kc], s1); }
                if (nvalid < 256) { const int sl = 32 * up + 4 * g4;
#pragma unroll
                    for (int i = 0; i < 4; ++i) { s0[i] = (sl + i < nvalid) ? s0[i] : NEG_INF; s1[i] = (sl + 16 + i < nvalid) ? s1[i] : NEG_INF; } }
                const float tm = xrow_max(fmaxf(fmaxf(fmaxf(s0[0], s0[1]), fmaxf(s0[2], s0[3])), fmaxf(fmaxf(s1[0], s1[1]), fmaxf(s1[2], s1[3]))));
                if (__ballot(tm > m_run) != 0ull) {
                    const float m_new = fmaxf(m_run, tm), alpha = __builtin_amdgcn_exp2f(m_run - m_new); m_run = m_new; l_run *= alpha;
#pragma unroll
                    for (int d = 0; d < 8; ++d) O[d] *= alpha;
                }
                float ps = 0.f;
#pragma unroll
                for (int i = 0; i < 4; ++i) { s0[i] = __builtin_amdgcn_exp2f(s0[i] - m_run); s1[i] = __builtin_amdgcn_exp2f(s1[i] - m_run); ps += s0[i] + s1[i]; }
                l_run += ps;
                const bf16x8 pa = pack8(s0, s1);
                const f32x4 z = {0.f, 0.f, 0.f, 0.f};
#pragma unroll
                for (int kc = 0; kc < 4; ++kc) {
                    const f32x4 a0 = MFMA16(c0[kc], e0, z), a1 = MFMA16(c1[kc], e0, z), b0 = MFMA16(c0[kc], e1, z), b1 = MFMA16(c1[kc], e1, z);
                    O[2 * kc] = MFMA16(pack8(a0, a1), pa, O[2 * kc]);
                    O[2 * kc + 1] = MFMA16(pack8(b0, b1), pa, O[2 * kc + 1]);
                }
            };
#pragma unroll 1
            for (int up = 0; up < npair; up += 2) {
                pair_body(f0, f1, n0, n1, up);
                if (up + 1 < npair) pair_body(n0, n1, f0, f1, up + 1);
            }
            l_run = xrow_sum(l_run);
            { const float inv = 1.0f / l_run;
              bf16_t* op = ((rep_ == DSA_REP_ATTN - 1) ? QCAT + tok * 2560 : (bf16_t*)(SC + (size_t)ql * 4096)) + ln * 128 + 4 * g4;
#pragma unroll
              for (int d = 0; d < 8; ++d) *(u32x2*)(op + 16 * d) = pack4(O[d] * inv); }
            }
#endif
            WAVE_LDS_FENCE();
#ifdef PROBE
            { const unsigned long long t1_ = __builtin_amdgcn_s_memrealtime(); if (blockIdx.x == PROBE_BLK && wave == 0 && lane == 0) ((LAS unsigned*)(lds + 150000))[1] += (unsigned)(t1_ - pt0_); pt0_ = t1_; }
#endif
        }
        __syncthreads();
    }
#ifdef PROBE
    if (blockIdx.x == PROBE_BLK && wave == 0 && lane == 0) { unsigned* st = (unsigned*)(p.ws + OFF_BAR + 16384); st[0] = ((LAS unsigned*)(lds + 150000))[0]; st[1] = ((LAS unsigned*)(lds + 150000))[1]; }
#endif
}

DI void phase_normB(const Params& p, int wave, int lane) {
    const int NW = gridDim.x * 8, gw = blockIdx.x * 8 + wave;
    const float* h = p.out; const float* gk = p.in[10]; const float* gb = p.in[12]; const float* mod = (const float*)(p.ws + OFF_MOD) + (size_t)NB * 3072;
    bf16_t* HKV = (bf16_t*)(p.ws + OFF_HKV); bf16_t* HNB = (bf16_t*)(p.ws + OFF_HNB);
#pragma unroll 1
    for (int row0 = gw * 4; row0 < M; row0 += NW * 4) {
        const int b = row0 >> 12;
        f32x4 v[4][4]; float rstd[4];
#pragma unroll
        for (int r = 0; r < 4; ++r)
#pragma unroll
            for (int j = 0; j < 4; ++j) v[r][j] = *((const f32x4*)(h + (size_t)(row0 + r) * 1024) + lane + 64 * j);
#pragma unroll
        for (int r = 0; r < 4; ++r) rstd[r] = 1.0f / sqrtf(wave_sum(row_ss(v[r])) * (1.0f / 1024) + EPS);
#pragma unroll
        for (int j = 0; j < 4; ++j) { const int col = 256 * j + 4 * lane;
            const f32x4 g1 = *(const f32x4*)(gk + col), g2 = *(const f32x4*)(gb + col), sh = *(const f32x4*)(mod + (size_t)b * 3072 + col), scv = *(const f32x4*)(mod + (size_t)b * 3072 + 1024 + col);
            const f32x4 gs = g2 * (scv + 1.0f);
#pragma unroll
            for (int r = 0; r < 4; ++r) { const f32x4 nv = v[r][j] * rstd[r];
                *(u32x2*)(HKV + (size_t)(row0 + r) * 1024 + col) = pack4(nv * g1);
                *(u32x2*)(HNB + (size_t)(row0 + r) * 1024 + col) = pack4(nv * gs + sh); } }
    }
}

DI void phase_dil(const Params& p, LAS unsigned char* lds, int wave, int lane) {
    unsigned char* ws = p.ws;
    const bf16_t* KB = (const bf16_t*)(ws + OFF_KB); const bf16_t* VB = (const bf16_t*)(ws + OFF_VB); bf16_t* Q3 = (bf16_t*)(ws + OFF_Q3); float* LSE = (float*)(ws + OFF_LSE);
    LAS unsigned char* KL = lds; LAS unsigned char* VL = lds + 69632;
    const int G = gridDim.x, tid = wave * 64 + lane;
    const float NEG_INF = -__builtin_huge_valf();
    u32x4 kst[8], vst[8]; bf16x8 qst[4];
    int it = blockIdx.x;
#define DIL_DECODE(IT) const int blkres = (IT) & 31, head = ((IT) >> 5) & 7, r1_ = (IT) >> 8, grp = r1_ % 3, b = r1_ / 3; \
        const int lg = grp * 2, nblk = 32 >> lg, res = blkres >> (5 - lg), blk = blkres & (nblk - 1); const size_t tok0 = (size_t)b * SEQ;
#define DIL_LOAD(IT) do { DIL_DECODE(IT) \
        _Pragma("unroll") for (int i = 0; i < 8; ++i) { const int id = tid_ + 512 * i, row = id >> 4, ch = id & 15; const int ks = blk * 128 - 128 + row; \
            const size_t off = (tok0 + ((size_t)(ks < 0 ? 0 : ks) << lg) + res) * 1024 + head * 128 + ch * 8; \
            kst[i] = *(const u32x4*)(KB + off); vst[i] = *(const u32x4*)(VB + off); } \
        { const size_t tq_ = tok0 + ((size_t)(blk * 128 + wave * 16 + (tid_ & 15)) << lg) + res; const bf16_t* qp_ = Q3 + (size_t)grp * M * 1024 + tq_ * 1024 + head * 128 + 8 * ((tid_ >> 4) & 3); \
          _Pragma("unroll") for (int kc = 0; kc < 4; ++kc) qst[kc] = *(const bf16x8*)(qp_ + 32 * kc); } } while (0)
    { int tid_ = tid; asm volatile("" : "+v"(tid_)); if (it < 12288) DIL_LOAD(it); }
#pragma unroll 1
    for (; it < 12288; it += G) {
        int tid_ = tid; asm volatile("" : "+v"(tid_));
        const int ln = tid_ & 15, g4 = (tid_ >> 4) & 3;
#pragma unroll
        for (int i = 0; i < 8; ++i) { const int id = tid_ + 512 * i, row = id >> 4, ch = id & 15;
            *(LAS u32x4*)(KL + row * 272 + ch * 16) = kst[i]; *(LAS u32x4*)(VL + row * 288 + ch * 16) = vst[i]; }
        bf16x8 qf[4];
#pragma unroll
        for (int kc = 0; kc < 4; ++kc) qf[kc] = qst[kc];
        __syncthreads();
        if (it + G < 12288) DIL_LOAD(it + G);
        DIL_DECODE(it)
        const int qt = wave, qsub0 = blk * 128 + qt * 16;
        bf16_t* Qg = Q3 + (size_t)grp * M * 1024;
        const size_t tokq = tok0 + ((size_t)(qsub0 + ln) << lg) + res;
        f32x4 st[9];
#pragma unroll
        for (int tl = 0; tl < 9; ++tl) {
            const LAS unsigned char* kp = KL + (16 * (qt + tl) + ln) * 272 + 16 * g4;
            f32x4 acc = {0.f, 0.f, 0.f, 0.f};
#pragma unroll
            for (int kc = 0; kc < 4; ++kc) acc = MFMA16(*(const LAS bf16x8*)(kp + 64 * kc), qf[kc], acc);
#pragma unroll
            for (int i = 0; i < 4; ++i) { const int ksi = qsub0 - 128 + 16 * tl + 4 * g4 + i, dist = qsub0 + ln - ksi;
                st[tl][i] = (dist >= 0 && dist <= 128 && ksi >= 0) ? acc[i] : NEG_INF; }
        }
        float mx = NEG_INF;
#pragma unroll
        for (int tl = 0; tl < 9; ++tl) mx = fmaxf(fmaxf(fmaxf(st[tl][0], st[tl][1]), fmaxf(st[tl][2], st[tl][3])), mx);
        mx = fmaxf(mx, __shfl_xor(mx, 16)); mx = fmaxf(mx, __shfl_xor(mx, 32));
        float sum = 0.f;
#pragma unroll
        for (int tl = 0; tl < 9; ++tl)
#pragma unroll
            for (int i = 0; i < 4; ++i) { const float e = __expf(st[tl][i] - mx); st[tl][i] = e; sum += e; }
        sum += __shfl_xor(sum, 16); sum += __shfl_xor(sum, 32);
        const float inv = 1.0f / sum;
        if (g4 == 0) LSE[((size_t)grp * M + tokq) * 8 + head] = mx + __logf(sum);
        f32x4 O[8];
#pragma unroll
        for (int d = 0; d < 8; ++d) O[d] = (f32x4){0.f, 0.f, 0.f, 0.f};
#pragma unroll
        for (int up = 0; up < 5; ++up) {
            const int t0 = 2 * up, t1 = (2 * up + 1 < 9) ? 2 * up + 1 : 8;
            const LAS unsigned char* vp0 = VL + (16 * (qt + t0) + 4 * g4 + (ln >> 2)) * 288 + 8 * (ln & 3); const LAS unsigned char* vp1 = VL + (16 * (qt + t1) + 4 * g4 + (ln >> 2)) * 288 + 8 * (ln & 3);
            const f32x4 z = {0.f, 0.f, 0.f, 0.f};
            const bf16x8 pa = pack8(st[t0] * inv, (2 * up + 1 < 9) ? st[t1] * inv : z);
#pragma unroll
            for (int d = 0; d < 8; ++d) {
                const s16x4 lo = __builtin_amdgcn_ds_read_tr16_b64_v4i16((LAS s16x4*)(vp0 + 32 * d)), hi = __builtin_amdgcn_ds_read_tr16_b64_v4i16((LAS s16x4*)(vp1 + 32 * d));
                O[d] = MFMA16(__builtin_shufflevector(lo, hi, 0, 1, 2, 3, 4, 5, 6, 7), pa, O[d]);
            }
        }
        { bf16_t* op = Qg + tokq * 1024 + head * 128 + 4 * g4;
#pragma unroll
          for (int d = 0; d < 8; ++d) *(u32x2*)(op + 16 * d) = pack4(O[d]); }
        __syncthreads();
    }
#undef DIL_DECODE
#undef DIL_LOAD
}
DI void phase_merge(const Params& p, int wave, int lane) {
    unsigned char* ws = p.ws;
    const int NW = gridDim.x * 8, gw = blockIdx.x * 8 + wave;
    const bf16_t* Q3 = (const bf16_t*)(ws + OFF_Q3); bf16_t* GB = (bf16_t*)(ws + OFF_GB); const float* LSE = (const float*)(ws + OFF_LSE);
    const int head = lane >> 3;
#pragma unroll 1
    for (int row0 = gw * 2; row0 < M; row0 += NW * 2) {
        float l[2][3]; u32x4 a[2][2], bq[2][2], cq[2][2], gg[2][2];
#pragma unroll
        for (int r = 0; r < 2; ++r) { const int row = row0 + r; const size_t off = (size_t)row * 1024 + 16 * lane;
            l[r][0] = LSE[((size_t)row) * 8 + head]; l[r][1] = LSE[((size_t)M + row) * 8 + head]; l[r][2] = LSE[((size_t)2 * M + row) * 8 + head];
#pragma unroll
            for (int hh = 0; hh < 2; ++hh) { a[r][hh] = *(const u32x4*)(Q3 + off + 8 * hh); bq[r][hh] = *(const u32x4*)(Q3 + (size_t)M * 1024 + off + 8 * hh);
                cq[r][hh] = *(const u32x4*)(Q3 + (size_t)2 * M * 1024 + off + 8 * hh); gg[r][hh] = *(const u32x4*)(GB + off + 8 * hh); } }
#pragma unroll
        for (int r = 0; r < 2; ++r) { const size_t off = (size_t)(row0 + r) * 1024 + 16 * lane;
            const float mx = fmaxf(l[r][0], fmaxf(l[r][1], l[r][2])); float w0 = __expf(l[r][0] - mx), w1 = __expf(l[r][1] - mx), w2 = __expf(l[r][2] - mx); const float inv = 1.0f / (w0 + w1 + w2);
            w0 *= inv; w1 *= inv; w2 *= inv;
#pragma unroll
            for (int hh = 0; hh < 2; ++hh) { u32x4 o;
#pragma unroll
                for (int j = 0; j < 4; ++j) { const float lo = (w0 * bflo(a[r][hh][j]) + w1 * bflo(bq[r][hh][j]) + w2 * bflo(cq[r][hh][j])) * bflo(gg[r][hh][j]);
                    const float hi = (w0 * bfhi(a[r][hh][j]) + w1 * bfhi(bq[r][hh][j]) + w2 * bfhi(cq[r][hh][j])) * bfhi(gg[r][hh][j]); o[j] = cvt_pk_bf16(lo, hi); }
                *(u32x4*)(GB + off + 8 * hh) = o; } }
    }
}
DI void phase_final(const Params& p, int wave, int lane) {
    const int NW = gridDim.x * 8, gw = blockIdx.x * 8 + wave;
    float* h = p.out; const float* g = p.in[17];
#pragma unroll 1
    for (int row0 = gw * 4; row0 < M; row0 += NW * 4) {
        f32x4 v[4][4]; float rstd[4];
#pragma unroll
        for (int r = 0; r < 4; ++r)
#pragma unroll
            for (int j = 0; j < 4; ++j) v[r][j] = *((const f32x4*)(h + (size_t)(row0 + r) * 1024) + lane + 64 * j);
#pragma unroll
        for (int r = 0; r < 4; ++r) rstd[r] = 1.0f / sqrtf(wave_sum(row_ss(v[r])) * (1.0f / 1024) + EPS);
#pragma unroll
        for (int j = 0; j < 4; ++j) { const f32x4 gv = *(const f32x4*)(g + 256 * j + 4 * lane);
#pragma unroll
            for (int r = 0; r < 4; ++r) *((f32x4*)(h + (size_t)(row0 + r) * 1024) + lane + 64 * j) = (v[r][j] * rstd[r]) * gv; }
    }
}

#define XB_TMO      128
#define XB_XCNT(j)  (256  + 64 * (j))
#define XB_XSUB(j)  (1280 + 64 * (j))
#define XB_XGEN(j)  (2304 + 64 * (j))
#define XB_TOP      3328
#define XB_TOPGEN   3392
#define XCD_BAR_WORDS 3456
#define XB_SPIN_CAP (1u << 18)

__device__ __forceinline__ unsigned xb_ld(unsigned* p)              { return __hip_atomic_load(p, __ATOMIC_RELAXED, __HIP_MEMORY_SCOPE_AGENT); }
__device__ __forceinline__ unsigned xb_add(unsigned* p, unsigned v) { return __hip_atomic_fetch_add(p, v, __ATOMIC_RELAXED, __HIP_MEMORY_SCOPE_AGENT); }
__device__ __forceinline__ unsigned xb_xcc_id() { return (unsigned)__builtin_amdgcn_s_getreg((3 << 11) | 20) & 0xFu; }
#define XB_SPIN(cond, bar) do { unsigned _sp = 0; while (cond) { __builtin_amdgcn_s_sleep(1); \
    if ((++_sp & 255u) == 0u) { if (xb_ld(&(bar)[XB_TMO])) break; if (_sp > XB_SPIN_CAP) { atomicAdd(&(bar)[XB_TMO], 1u); break; } } } } while (0)

struct XcdBarrier {
    unsigned* bar; unsigned x;
    volatile LAS unsigned* st;
};

__device__ __forceinline__ XcdBarrier xcd_barrier_post(unsigned* bar, volatile LAS unsigned* st, const bool lead) {
    XcdBarrier b; b.bar = bar; b.x = xb_xcc_id(); b.st = st;
    if (lead) (void)xb_add(&bar[XB_XCNT(b.x)], 1u);
    return b;
}
__device__ __forceinline__ void xcd_barrier_complete(unsigned* bar, unsigned x, unsigned& nloc, unsigned& nx) {
    const unsigned G = gridDim.x * gridDim.y * gridDim.z;
    unsigned sum, cnt, mine, sp = 0u;
    for (;;) {
        sum = 0u; cnt = 0u; mine = 0u;
#pragma unroll
        for (unsigned j = 0; j < 16; ++j) { const unsigned c = xb_ld(&bar[XB_XCNT(j)]); sum += c; cnt += (c > 0u) ? 1u : 0u; mine = (j == x) ? c : mine; }
        if (sum == G) break;
        __builtin_amdgcn_s_sleep(1);
        if ((++sp & 255u) == 0u) { if (xb_ld(&bar[XB_TMO])) break; if (sp > XB_SPIN_CAP) { atomicAdd(&bar[XB_TMO], 1u); break; } }
    }
    nloc = mine > 0u ? mine : 1u; nx = cnt > 0u ? cnt : 1u;
}

__device__ __forceinline__ void xcd_barrier(const XcdBarrier& b, const int wave) {
    asm volatile("s_waitcnt vmcnt(0)" ::: "memory");
    __syncthreads();
    if (wave == 0 && pg8::opaque_lane() == 0) {
        unsigned* bar = b.bar;
        __builtin_amdgcn_s_waitcnt(0);
        unsigned nloc = b.st[0], nx = b.st[1];
        if (nloc == 0u) { xcd_barrier_complete(bar, b.x, nloc, nx); b.st[0] = nloc; b.st[1] = nx; }
        const unsigned old = xb_add(&bar[XB_XSUB(b.x)], 1u);
        const unsigned gen = old / nloc;
        if (old + 1u == (gen + 1u) * nloc) {
            __builtin_amdgcn_fence(__ATOMIC_RELEASE, "agent");
            asm volatile("s_waitcnt vmcnt(0)" ::: "memory");
            const unsigned og = xb_add(&bar[XB_TOP], 1u);
            const unsigned tg = og / nx;
            if (og + 1u == (tg + 1u) * nx) xb_add(&bar[XB_TOPGEN], 1u);
            else XB_SPIN(xb_ld(&bar[XB_TOPGEN]) == tg, bar);
            __builtin_amdgcn_fence(__ATOMIC_ACQUIRE, "agent");
            xb_add(&bar[XB_XGEN(b.x)], 1u);
            asm volatile("s_waitcnt vmcnt(0)" ::: "memory");
        } else {
            XB_SPIN(xb_ld(&bar[XB_XGEN(b.x)]) == gen, bar);
            __builtin_amdgcn_fence(__ATOMIC_ACQUIRE, "agent");
            asm volatile("s_waitcnt vmcnt(0)" ::: "memory");
        }
    }
    __syncthreads();
}


extern __shared__ __attribute__((aligned(16))) unsigned char smem_raw[];

__global__ void __launch_bounds__(512) yoco_fwd(Params p) {
    cg::grid_group grid = cg::this_grid();
    LAS unsigned char* lds = (LAS unsigned char*)smem_raw;
    const int wave = __builtin_amdgcn_readfirstlane(threadIdx.x >> 6);
    unsigned char* ws = p.ws;
    pg8::StaticOrder S;
    const int G = gridDim.x, c = blockIdx.x;
    const float* modA = (const float*)(ws + OFF_MOD); const float* modB = modA + (size_t)NB * 3072;
    unsigned* bar = (unsigned*)(ws + OFF_BAR);
    volatile LAS unsigned* xst = (volatile LAS unsigned*)(lds + LDS_BYTES - 16);
    const bool lead_ = (wave == 0) && (pg8::opaque_lane() == 0);
    if (lead_) { xst[0] = 0u; xst[1] = 0u; }
    __syncthreads();
    const XcdBarrier xb = xcd_barrier_post(bar, xst, lead_);
    { { const int lane = pg8::opaque_lane(); phase0(p, lds, wave * 64 + lane, wave, lane); } }
    if (p.ws == nullptr) grid.sync();
    xcd_barrier(xb, wave);
#ifdef PROBE
    if (blockIdx.x == 0 && threadIdx.x == 0) ((unsigned long long*)(ws + OFF_BAR + 32768))[0] = __builtin_amdgcn_s_memrealtime();
#endif
    { { const int lane = pg8::opaque_lane(); phase_hnA(p, wave, lane); } }
    xcd_barrier(xb, wave);
#ifdef PROBE
    if (blockIdx.x == 0 && threadIdx.x == 0) ((unsigned long long*)(ws + OFF_BAR + 32768))[1] = __builtin_amdgcn_s_memrealtime();
#endif
    { {
        { pg8::Gemm g{(const bf16_t*)p.out, (const bf16_t*)(ws + OFF_WA_MAIN), M, 4864, 1024, 2048, 1024, 0, -1}; S.init(M, 4864, G, c);
          EpiAMain E{(bf16_t*)(ws + OFF_QCAT), (bf16_t*)(ws + OFF_GATE), (bf16_t*)(ws + OFF_KEYS), (float*)(ws + OFF_CKV), (const float*)(ws + OFF_ROPE_A), p.in[7], (LAS float*)(lds + 131072)};
          pg8::gemm_phase<EpiAMain, pg8::StaticOrder, false>(lds, g, S, E, nullptr, wave); }
        { pg8::Gemm g{(const bf16_t*)p.out, (const bf16_t*)(ws + OFF_WA_IDX), M, 768, 3072, 2048, 2048, 0, 2}; S.init(M, 768, G, c);
          EpiAIdx E{(bf16_t*)(ws + OFF_QIDX), (bf16_t*)(ws + OFF_KIDX), (float*)(ws + OFF_WIDX), (const float*)(ws + OFF_ROPE_I)};
          pg8::gemm_phase<EpiAIdx, pg8::StaticOrder, true>(lds, g, S, E, nullptr, wave); }
    } }
    xcd_barrier(xb, wave);
#ifdef PROBE
    if (blockIdx.x == 0 && threadIdx.x == 0) ((unsigned long long*)(ws + OFF_BAR + 32768))[2] = __builtin_amdgcn_s_memrealtime();
#endif
    { { const int lane = pg8::opaque_lane(); phase_dsa(p, lds, wave * 64 + lane, wave, lane); } }
    xcd_barrier(xb, wave);
#ifdef PROBE
    if (blockIdx.x == 0 && threadIdx.x == 0) ((unsigned long long*)(ws + OFF_BAR + 32768))[3] = __builtin_amdgcn_s_memrealtime();
#endif
    { { pg8::Gemm g{(const bf16_t*)(ws + OFF_QCAT), (const bf16_t*)(ws + OFF_WUV), M, 2048, 256, 2560, 256, 256, -2}; S.init(M, 2048, G, c);
        EpiUV E{(bf16_t*)(ws + OFF_GATE)}; pg8::gemm_phase<EpiUV, pg8::StaticOrder, false>(lds, g, S, E, nullptr, wave); } }
    xcd_barrier(xb, wave);
#ifdef PROBE
    if (blockIdx.x == 0 && threadIdx.x == 0) ((unsigned long long*)(ws + OFF_BAR + 32768))[4] = __builtin_amdgcn_s_memrealtime();
#endif
    { { pg8::Gemm g{(const bf16_t*)(ws + OFF_GATE), (const bf16_t*)(ws + OFF_WAO), M, 1024, 2048, 2048, 2048, 0, -1}; S.init(M, 1024, G, c);
        EpiRes E{p.in[0], p.out, modA + 2048}; pg8::gemm_phase<EpiRes, pg8::StaticOrder, false>(lds, g, S, E, nullptr, wave); } }
    xcd_barrier(xb, wave);
#ifdef PROBE
    if (blockIdx.x == 0 && threadIdx.x == 0) ((unsigned long long*)(ws + OFF_BAR + 32768))[5] = __builtin_amdgcn_s_memrealtime();
#endif
    { { const int lane = pg8::opaque_lane(); phase_normB(p, wave, lane); } }
    xcd_barrier(xb, wave);
#ifdef PROBE
    if (blockIdx.x == 0 && threadIdx.x == 0) ((unsigned long long*)(ws + OFF_BAR + 32768))[6] = __builtin_amdgcn_s_memrealtime();
#endif
    { { pg8::Gemm g{(const bf16_t*)(ws + OFF_HKV), (const bf16_t*)(ws + OFF_WKV), M, 2048, 1024, 1024, 1024, 0, -1}; S.init(M, 2048, G, c);
        EpiKV E{(bf16_t*)(ws + OFF_KB), (bf16_t*)(ws + OFF_VB), (const float*)(ws + OFF_ROPE_B)}; pg8::gemm_phase<EpiKV, pg8::StaticOrder, false>(lds, g, S, E, nullptr, wave); } }
    xcd_barrier(xb, wave);
#ifdef PROBE
    if (blockIdx.x == 0 && threadIdx.x == 0) ((unsigned long long*)(ws + OFF_BAR + 32768))[7] = __builtin_amdgcn_s_memrealtime();
#endif
    { { pg8::Gemm g{(const bf16_t*)(ws + OFF_HNB), (const bf16_t*)(ws + OFF_WBI), M, 4096, 1024, 1024, 1024, 0, -1}; S.init(M, 4096, G, c);
        EpiBIn E{(bf16_t*)(ws + OFF_Q3), (bf16_t*)(ws + OFF_GB), (const float*)(ws + OFF_ROPE_B)}; pg8::gemm_phase<EpiBIn, pg8::StaticOrder, false>(lds, g, S, E, nullptr, wave); } }
    xcd_barrier(xb, wave);
#ifdef PROBE
    if (blockIdx.x == 0 && threadIdx.x == 0) ((unsigned long long*)(ws + OFF_BAR + 32768))[8] = __builtin_amdgcn_s_memrealtime();
#endif
    { { const int lane = pg8::opaque_lane(); phase_dil(p, lds, wave, lane); } }
    xcd_barrier(xb, wave);
#ifdef PROBE
    if (blockIdx.x == 0 && threadIdx.x == 0) ((unsigned long long*)(ws + OFF_BAR + 32768))[9] = __builtin_amdgcn_s_memrealtime();
#endif
    { { const int lane = pg8::opaque_lane(); phase_merge(p, wave, lane); } }
    xcd_barrier(xb, wave);
#ifdef PROBE
    if (blockIdx.x == 0 && threadIdx.x == 0) ((unsigned long long*)(ws + OFF_BAR + 32768))[10] = __builtin_amdgcn_s_memrealtime();
#endif
    { { pg8::Gemm g{(const bf16_t*)(ws + OFF_GB), (const bf16_t*)(ws + OFF_WBO), M, 1024, 1024, 1024, 1024, 0, -1}; S.init(M, 1024, G, c);
        EpiRes E{p.out, p.out, modB + 2048}; pg8::gemm_phase<EpiRes, pg8::StaticOrder, false>(lds, g, S, E, nullptr, wave); } }
    xcd_barrier(xb, wave);
#ifdef PROBE
    if (blockIdx.x == 0 && threadIdx.x == 0) ((unsigned long long*)(ws + OFF_BAR + 32768))[11] = __builtin_amdgcn_s_memrealtime();
#endif
    { { const int lane = pg8::opaque_lane(); phase_final(p, wave, lane); } }
#ifdef PROBE
    if (blockIdx.x == 0 && threadIdx.x == 0) { const unsigned long long* ts = (const unsigned long long*)(ws + OFF_BAR + 32768); const unsigned* st = (const unsigned*)(ws + OFF_BAR + 16384);
        const float v1 = (float)(ts[PROBE_S1] - ts[PROBE_S0]) * 0.01f;
        const float v2 = (float)st[PROBE_SUB] * 0.01f;
        p.out[0] = v1; if (v2 > 0.f) for (int i = 1; i <= 65536; ++i) p.out[i] = v2; }
#endif
}

extern "C" void kernel_launch(void* const* d_in, const int* in_sizes, int n_in, void* d_out, int out_size, void* d_ws, size_t ws_size, hipStream_t stream) {
    static int grid_blocks = 0;
    if (grid_blocks == 0) {
        if (n_in != 18 || out_size != M * D || ws_size < WS_NEED) { fprintf(stderr, "kernel_launch: unexpected shapes (n_in %d out %d ws %zu need %zu)\n", n_in, out_size, ws_size, (size_t)WS_NEED); grid_blocks = -1; return; }
        int dev = 0, cus = 0, per_cu = 0;
        hipGetDevice(&dev); hipDeviceGetAttribute(&cus, hipDeviceAttributeMultiprocessorCount, dev);
        if (hipFuncSetAttribute((const void*)yoco_fwd, hipFuncAttributeMaxDynamicSharedMemorySize, LDS_BYTES) != hipSuccess) { fprintf(stderr, "kernel_launch: hipFuncSetAttribute failed\n"); grid_blocks = -1; return; }
        if (hipOccupancyMaxActiveBlocksPerMultiprocessor(&per_cu, (const void*)yoco_fwd, 512, LDS_BYTES) != hipSuccess || per_cu < 1) { fprintf(stderr, "kernel_launch: occupancy query gave %d\n", per_cu); per_cu = 1; }
        (void)hipGetLastError();
        grid_blocks = cus * per_cu; if (grid_blocks > MAX_GRID) grid_blocks = MAX_GRID;
    }
    if (grid_blocks < 0) return;
    if (hipMemsetAsync((char*)d_ws + OFF_BAR, 0, XCD_BAR_WORDS * 4, stream) != hipSuccess) { fprintf(stderr, "kernel_launch: memset failed\n"); return; }
    Params p{};
    for (int i = 0; i < 18; ++i) p.in[i] = (const float*)d_in[i];
    p.out = (float*)d_out; p.ws = (unsigned char*)d_ws;
    void* args[] = {&p};
    hipError_t e = hipLaunchCooperativeKernel((const void*)yoco_fwd, dim3(grid_blocks), dim3(512), args, LDS_BYTES, stream);
    if (e != hipSuccess) fprintf(stderr, "cooperative launch failed: %s (grid %d)\n", hipGetErrorString(e), grid_blocks);
}
```

```cpp
#include <hip/hip_runtime.h>
#include <hip/hip_cooperative_groups.h>
#include <cstdio>
#include <cstdint>
namespace cg = cooperative_groups;

namespace pg8 {
#define PG8_LAS __attribute__((address_space(3)))
typedef unsigned short bf16_t;
typedef short bf16x8 __attribute__((ext_vector_type(8)));
typedef float f32x4 __attribute__((ext_vector_type(4)));
typedef unsigned u32x4 __attribute__((ext_vector_type(4)));
constexpr int BM = 256, BK = 64, HALF = 128, HTB = HALF * BK * 2  , STAGE_BYTES = 8 * HTB, NXCD = 8, WGM = 4;

__host__ __device__ __forceinline__ int lds_byte(int r, int c) { const int st = (r >> 4) * 2 + (c >> 5), rr = r & 15, cc = c & 31, ob = rr * 64 + cc * 2; return st * 1024 + (ob ^ (((ob >> 9) & 1) << 5)); }
__host__ __device__ __forceinline__ void stage_rc(int b, int& R, int& C) { const int st = b / 1024, sb = b % 1024, swz = sb ^ (((sb >> 9) & 1) << 5); R = (st >> 1) * 16 + swz / 64; C = (st & 1) * 32 + (swz % 64) / 2; }
__host__ __device__ __forceinline__ int perm32(int rho) { const int n = rho >> 4, i = rho & 15; return 8 * (i >> 2) + 4 * n + (i & 3); }

struct Unit { int pm, pn; };
struct Gemm { const bf16_t* A; const bf16_t* Bt; int M, N, K, lda, ldb, aoff_pn, b1zero_pn; };

struct StaticOrder {
    int nM, nN, nwg, G, c;
    __host__ __device__ void init(int M, int N, int G_, int c_) { nM = M / BM; nN = N / BM; nwg = nM * nN; G = G_; c = c_; }
    __host__ __device__ bool next(int i, Unit& u) const {
        const long L = (long)i * G + c; if (L >= nwg) return false;
        int wgid = (int)L; { const int q = nwg / NXCD, r = nwg % NXCD, xcd = wgid % NXCD, off = wgid / NXCD; wgid = (xcd < r ? xcd * (q + 1) : r * (q + 1) + (xcd - r) * q) + off; }
        const int nig = WGM * nN, gid = wgid / nig, fm = gid * WGM, gsz = (nM - fm) < WGM ? (nM - fm) : WGM;
        u.pm = fm + ((wgid % nig) % gsz); u.pn = (wgid % nig) / gsz; return true;
    }
    __device__ __forceinline__ void a_ready(const Unit&) const {}
    __device__ __forceinline__ void done(const Unit&) const {}
};

struct RowOwnerOrder {
    int nN, c;
    __host__ __device__ void init(int, int N, int, int c_) { nN = N / BM; c = c_; }
    __host__ __device__ bool next(int i, Unit& u) const { if (i >= nN) return false; u.pm = c; u.pn = i; return true; }
    __device__ __forceinline__ void a_ready(const Unit&) const {}
    __device__ __forceinline__ void done(const Unit&) const {}
};
__device__ __forceinline__ int opaque_lane() { int l; asm volatile("v_mbcnt_lo_u32_b32 %0, -1, 0\n\tv_mbcnt_hi_u32_b32 %0, -1, %0" : "=v"(l)); return l; }
template <class Epi, class Sched, bool SPLIT = false, bool ALIGN_EPI = true, bool SP2 = true>
__device__ __forceinline__ void gemm_phase(PG8_LAS unsigned char* lds, const Gemm g, const Sched& S, const Epi& E, unsigned long long*, const int wave_in) {
    const int lane = opaque_lane(), wid = wave_in, tid = wid * 64 + lane, wr = wid >> 2, wc = wid & 3, fr = lane & 15, fq = lane >> 4;
    const int K = g.K, nt = SPLIT ? 48 : K / BK; const int lda = g.lda, ldb = g.ldb; (void)K;
    unsigned voffA[2], voffB[2];
#pragma unroll
    for (int i = 0; i < 2; ++i) { int R, C; stage_rc(tid * 16 + i * 8192, R, C); const int Rb = Epi::PERM ? ((R & ~31) + perm32(R & 31)) : R;
        voffA[i] = (unsigned)(R * lda + C) * 2u; voffB[i] = (unsigned)(Rb * ldb + C) * 2u; }
    const size_t kstep = (size_t)(BK * 2);
    const size_t hstepA = (size_t)HALF * lda * 2, hstepB = (size_t)HALF * ldb * 2;
    const size_t tstepA = 2 * hstepA, tstepB = 2 * hstepB, pnoffA = (size_t)g.aoff_pn * 2;
    const unsigned ldsw = (unsigned)wid * 1024u;
    const int aoff = lds_byte(wr * 64 + fr, fq * 8), boff = lds_byte(wc * 32 + fr, fq * 8);
#define PG8_SA(b, h) (((b) * 2 + (h)) * HTB)
#define PG8_SB(b, h) ((4 + (b) * 2 + (h)) * HTB)
#define PG8_STAGE(bufoff, gbase, voff) do { _Pragma("unroll") for (int _i = 0; _i < 2; ++_i) \
        __builtin_amdgcn_global_load_lds((const unsigned*)((const char*)(gbase) + (voff)[_i]), (PG8_LAS unsigned*)(lds + (bufoff) + ldsw + _i * 8192), 16, 0, 0); } while (0)
#define PG8_LDA(dst, b, h) do { _Pragma("unroll") for (int m = 0; m < 4; ++m) _Pragma("unroll") for (int k = 0; k < 2; ++k) dst[m][k] = *(const PG8_LAS bf16x8*)(lds + PG8_SA(b, h) + aoff + m * 2048 + k * 1024); } while (0)
#define PG8_LDB(dst, b, h) do { _Pragma("unroll") for (int n = 0; n < 2; ++n) _Pragma("unroll") for (int k = 0; k < 2; ++k) dst[n][k] = *(const PG8_LAS bf16x8*)(lds + PG8_SB(b, h) + boff + n * 2048 + k * 1024); } while (0)
#define PG8_MMA(ai, bj, At, Bt) do { __builtin_amdgcn_s_setprio(1); _Pragma("unroll") for (int m = 0; m < 4; ++m) _Pragma("unroll") for (int n = 0; n < 2; ++n) _Pragma("unroll") for (int k = 0; k < 2; ++k) \
        acc[ai][bj][m][n] = __builtin_amdgcn_mfma_f32_16x16x32_bf16(Bt[n][k], At[m][k], acc[ai][bj][m][n], 0, 0, 0); __builtin_amdgcn_s_setprio(0); } while (0)
#define PG8_WAIT_V(n) asm volatile("s_waitcnt vmcnt(" #n ")" ::: "memory")
#define PG8_WAIT_L(n) asm volatile("s_waitcnt lgkmcnt(" #n ")" ::: "memory")
#define PG8_BAR __builtin_amdgcn_s_barrier()
#define PG8_SCHED __builtin_amdgcn_sched_barrier(0)
#define KTA(t) (SPLIT ? ((t) < 32 ? (t) : (t) - 32) : (t))
#define KTB(t) (SPLIT ? ((t) < 16 ? (t) : (t) - 16) : (t))
    Unit cur, nxt; int ui = 0;
    if (!S.next(0, cur)) return;
    bool b1z = g.b1zero_pn >= 0 && cur.pn == g.b1zero_pn;
    f32x4 acc[2][2][4][2];
#pragma unroll
    for (int a = 0; a < 2; ++a)
#pragma unroll
        for (int b = 0; b < 2; ++b)
#pragma unroll
            for (int m = 0; m < 4; ++m)
#pragma unroll
                for (int n = 0; n < 2; ++n) acc[a][b][m][n] = (f32x4){0.f, 0.f, 0.f, 0.f};
    bf16x8 At[4][2], B0[2][2], B1[2][2];
    const char* cA = (const char*)g.A + (size_t)cur.pm * tstepA + (size_t)cur.pn * pnoffA; const char* cB = (const char*)g.Bt + (size_t)cur.pn * tstepB;
    S.a_ready(cur);
    if constexpr (SP2) {
        PG8_STAGE(PG8_SB(0, 0), cB, voffB); PG8_STAGE(PG8_SB(0, 1), cB + hstepB, voffB); PG8_STAGE(PG8_SA(0, 0), cA, voffA); PG8_STAGE(PG8_SA(0, 1), cA + hstepA, voffA);
        if (wr == 1) PG8_BAR;
        PG8_WAIT_V(2); PG8_BAR;
        PG8_STAGE(PG8_SB(1, 0), cB + kstep, voffB); PG8_STAGE(PG8_SA(1, 0), cA + kstep, voffA); PG8_STAGE(PG8_SB(1, 1), cB + hstepB + kstep, voffB);
        PG8_WAIT_V(6); PG8_BAR;
    } else {
        PG8_STAGE(PG8_SB(0, 0), cB, voffB); PG8_STAGE(PG8_SA(0, 0), cA, voffA); PG8_STAGE(PG8_SB(0, 1), cB + hstepB, voffB); PG8_STAGE(PG8_SA(0, 1), cA + hstepA, voffA);
        if (wr == 1) PG8_BAR;
        PG8_WAIT_V(4); PG8_BAR;
        PG8_STAGE(PG8_SB(1, 0), cB + kstep, voffB); PG8_STAGE(PG8_SA(1, 0), cA + kstep, voffA); PG8_STAGE(PG8_SB(1, 1), cB + hstepB + kstep, voffB);
        PG8_WAIT_V(6); PG8_BAR;
    }
    for (;;) {
        const bool has_next = S.next(ui + 1, nxt);
        const char* nA = has_next ? (const char*)g.A + (size_t)nxt.pm * tstepA + (size_t)nxt.pn * pnoffA : cA; const char* nB = has_next ? (const char*)g.Bt + (size_t)nxt.pn * tstepB : cB;
#pragma unroll 1
        for (int t = 0; t < nt; t += 2) {
            const bool last = (t == nt - 2);
            const char* a1 = cA + (size_t)KTA(t + 1) * kstep;
            const char* a2 = last ? nA : cA + (size_t)KTA(t + 2) * kstep; const char* b2 = last ? nB : cB + (size_t)KTB(t + 2) * kstep;
            const char* a3 = a2 + kstep; const char* b3 = b2 + kstep;
            if (last && has_next) S.a_ready(nxt);
            if constexpr (SP2) {
            PG8_LDB(B0, 0, 0); PG8_LDB(B1, 0, 1); PG8_SCHED; PG8_LDA(At, 0, 0); PG8_STAGE(PG8_SA(1, 1), a1 + hstepA, voffA);
            PG8_WAIT_V(8); PG8_WAIT_L(0); PG8_BAR; PG8_MMA(0, 0, At, B0); if (!b1z) PG8_MMA(0, 1, At, B1); PG8_BAR; PG8_SCHED;
            PG8_LDA(At, 0, 1); PG8_STAGE(PG8_SB(0, 0), b2, voffB); PG8_STAGE(PG8_SB(0, 1), b2 + hstepB, voffB); PG8_STAGE(PG8_SA(0, 0), a2, voffA);
            PG8_WAIT_V(8); PG8_WAIT_L(0); PG8_BAR; PG8_MMA(1, 0, At, B0); if (!b1z) PG8_MMA(1, 1, At, B1); PG8_BAR; PG8_SCHED;
            PG8_LDB(B0, 1, 0); PG8_LDB(B1, 1, 1); PG8_SCHED; PG8_LDA(At, 1, 0); PG8_STAGE(PG8_SA(0, 1), a2 + hstepA, voffA);
            PG8_WAIT_V(8); PG8_WAIT_L(0); PG8_BAR; PG8_MMA(0, 0, At, B0); if (!b1z) PG8_MMA(0, 1, At, B1); PG8_BAR; PG8_SCHED;
            PG8_LDA(At, 1, 1); PG8_STAGE(PG8_SB(1, 0), b3, voffB); PG8_STAGE(PG8_SB(1, 1), b3 + hstepB, voffB); PG8_STAGE(PG8_SA(1, 0), a3, voffA);
            PG8_WAIT_V(8); PG8_WAIT_L(0); PG8_BAR; PG8_MMA(1, 0, At, B0); if (!b1z) PG8_MMA(1, 1, At, B1); PG8_BAR; PG8_SCHED;
            } else {
            PG8_LDB(B0, 0, 0); PG8_SCHED; PG8_LDA(At, 0, 0); PG8_STAGE(PG8_SA(1, 1), a1 + hstepA, voffA);
            PG8_WAIT_L(8); PG8_BAR; PG8_WAIT_L(0); PG8_MMA(0, 0, At, B0); PG8_BAR; PG8_SCHED;
            PG8_LDB(B1, 0, 1); PG8_STAGE(PG8_SB(0, 0), b2, voffB);
            PG8_BAR; PG8_WAIT_L(0); PG8_MMA(0, 1, At, B1); PG8_BAR;
            PG8_LDA(At, 0, 1); PG8_STAGE(PG8_SA(0, 0), a2, voffA);
            PG8_BAR; PG8_WAIT_L(0); PG8_MMA(1, 0, At, B0); PG8_BAR; PG8_SCHED;
            PG8_STAGE(PG8_SB(0, 1), b2 + hstepB, voffB);
            PG8_WAIT_V(6); PG8_BAR; PG8_MMA(1, 1, At, B1); PG8_BAR;
            PG8_LDB(B0, 1, 0); PG8_SCHED; PG8_LDA(At, 1, 0); PG8_STAGE(PG8_SA(0, 1), a2 + hstepA, voffA);
            PG8_WAIT_L(8); PG8_BAR; PG8_WAIT_L(0); PG8_MMA(0, 0, At, B0); PG8_BAR; PG8_SCHED;
            PG8_LDB(B1, 1, 1); PG8_STAGE(PG8_SB(1, 0), b3, voffB);
            PG8_BAR; PG8_WAIT_L(0); PG8_MMA(0, 1, At, B1); PG8_BAR;
            PG8_LDA(At, 1, 1); PG8_STAGE(PG8_SA(1, 0), a3, voffA);
            PG8_BAR; PG8_WAIT_L(0); PG8_MMA(1, 0, At, B0); PG8_BAR; PG8_SCHED;
            PG8_STAGE(PG8_SB(1, 1), b3 + hstepB, voffB);
            PG8_WAIT_V(6); PG8_BAR; PG8_MMA(1, 1, At, B1); PG8_BAR;
            }
        }
        if constexpr (ALIGN_EPI) { if (wr == 0) PG8_BAR; }
        if constexpr (!Epi::AFTER_DRAIN) { E(acc, cur, wr, wc, fr, fq); S.done(cur); }
        if (!has_next) break;
#pragma unroll
        for (int a = 0; a < 2; ++a)
#pragma unroll
            for (int b = 0; b < 2; ++b)
#pragma unroll
                for (int m = 0; m < 4; ++m)
#pragma unroll
                    for (int n = 0; n < 2; ++n) acc[a][b][m][n] = (f32x4){0.f, 0.f, 0.f, 0.f};
        cur = nxt; cA = nA; cB = nB; ++ui; b1z = g.b1zero_pn >= 0 && cur.pn == g.b1zero_pn;
        if constexpr (ALIGN_EPI) { if (wr == 1) PG8_BAR; }
    }
    PG8_WAIT_V(0);
    if constexpr (!ALIGN_EPI) { if (wr == 0) PG8_BAR; }
    PG8_BAR;
    if constexpr (Epi::AFTER_DRAIN) { E.fused(acc, cur, wr, wc, fr, fq, lds, wid, lane); S.done(cur); }
#undef PG8_SA
#undef PG8_SB
#undef PG8_STAGE
#undef PG8_LDA
#undef PG8_LDB
#undef PG8_MMA
#undef PG8_WAIT_V
#undef PG8_WAIT_L
#undef PG8_BAR
#undef PG8_SCHED
#undef KTA
#undef KTB
}
}

using pg8::bf16_t; using pg8::bf16x8; using pg8::f32x4; using pg8::u32x4; using pg8::Unit;
#define LAS __attribute__((address_space(3)))
#define DI __device__ __forceinline__
typedef float f32x16 __attribute__((ext_vector_type(16)));
typedef unsigned u32x2 __attribute__((ext_vector_type(2)));
typedef float f32x2 __attribute__((ext_vector_type(2)));
typedef short s16x4 __attribute__((ext_vector_type(4)));

constexpr int D = 1024, NB = 16, SEQ = 4096, M = NB * SEQ;
constexpr float EPS = 1e-6f;
constexpr size_t MBy = (size_t)1 << 20;
constexpr size_t OFF_WA_MAIN = 0, OFF_WA_IDX = 10 * MBy, OFF_WUV = 13 * MBy, OFF_WAO = 14 * MBy, OFF_WKV = 18 * MBy, OFF_WBI = 22 * MBy, OFF_WBO = 30 * MBy,
                 OFF_MOD = 32 * MBy, OFF_ROPE_A = 33 * MBy, OFF_ROPE_I = 41 * MBy, OFF_ROPE_B = 57 * MBy, OFF_ACT = 89 * MBy;
constexpr size_t OFF_QCAT = OFF_ACT, OFF_GATE = OFF_QCAT + 320 * MBy, OFF_QIDX = OFF_GATE + 256 * MBy, OFF_KEYS = OFF_QIDX + 128 * MBy, OFF_KIDX = OFF_KEYS + 20 * MBy,
                 OFF_WIDX = OFF_KIDX + 16 * MBy, OFF_CKV = OFF_WIDX + 2 * MBy, OFF_SC = OFF_CKV + 32 * MBy, END_A = OFF_SC + 128 * MBy;
constexpr size_t OFF_HNB = OFF_ACT, OFF_KB = OFF_HNB + 128 * MBy, OFF_VB = OFF_KB + 128 * MBy, OFF_Q3 = OFF_VB + 128 * MBy, OFF_GB = OFF_Q3 + 384 * MBy, OFF_HKV = OFF_GB,
                 OFF_LSE = OFF_GB + 128 * MBy, END_B = OFF_LSE + 6 * MBy;
constexpr size_t WS_NEED = END_A > END_B ? END_A : END_B;
constexpr size_t OFF_BAR = OFF_MOD + 768 * 1024;
constexpr int KROW = 160;
constexpr int LDS_BYTES = 152 * 1024;
constexpr int MAX_GRID = 256;

struct Params {
    const float* in[18];
    float* out; unsigned char* ws;
};

typedef __bf16 bf16x2_t __attribute__((ext_vector_type(2)));
DI unsigned cvt_pk_bf16(float lo, float hi) { const f32x2 f = {lo, hi}; const bf16x2_t v = __builtin_convertvector(f, bf16x2_t); return __builtin_bit_cast(unsigned, v); }
DI float bflo(unsigned w) { return __uint_as_float(w << 16); }
DI float bfhi(unsigned w) { return __uint_as_float(w & 0xffff0000u); }
DI float wave_sum(float v) {
#pragma unroll
    for (int o = 1; o < 64; o <<= 1) v += __shfl_xor(v, o);
    return v;
}
DI float silu_f(float x) { return x * (1.0f / (1.0f + __expf(-x))); }
DI u32x2 pack4(const f32x4& v) { u32x2 w; w.x = cvt_pk_bf16(v[0], v[1]); w.y = cvt_pk_bf16(v[2], v[3]); return w; }
DI f32x4 unpack4(const u32x2& w) { return (f32x4){bflo(w.x), bfhi(w.x), bflo(w.y), bfhi(w.y)}; }
#define WAVE_LDS_FENCE() asm volatile("s_waitcnt lgkmcnt(0)" ::: "memory")

DI float xrow_max(float x) {
    { const auto r = __builtin_amdgcn_permlane32_swap(__float_as_uint(x), __float_as_uint(x), false, false); x = fmaxf(__uint_as_float(r[0]), __uint_as_float(r[1])); }
    { const auto r = __builtin_amdgcn_permlane16_swap(__float_as_uint(x), __float_as_uint(x), false, false); x = fmaxf(__uint_as_float(r[0]), __uint_as_float(r[1])); }
    return x; }
DI float xrow_sum(float x) {
    { const auto r = __builtin_amdgcn_permlane32_swap(__float_as_uint(x), __float_as_uint(x), false, false); x = __uint_as_float(r[0]) + __uint_as_float(r[1]); }
    { const auto r = __builtin_amdgcn_permlane16_swap(__float_as_uint(x), __float_as_uint(x), false, false); x = __uint_as_float(r[0]) + __uint_as_float(r[1]); }
    return x; }
DI void rope4(const f32x4& x1, const f32x4& x2, const f32x4& t0, const f32x4& t1, float sc, f32x4& o1, f32x4& o2) {
    const f32x4 c = {t0[0], t0[2], t1[0], t1[2]}, s = {t0[1], t0[3], t1[1], t1[3]};
    o1 = (x1 * c - x2 * s) * sc; o2 = (x2 * c + x1 * s) * sc;
}
#define EPI_ROWS_BEGIN _Pragma("unroll") for (int ai = 0; ai < 2; ++ai) _Pragma("unroll") for (int m = 0; m < 4; ++m) { const int row = row0 + ai * 128 + m * 16;
#define EPI_ROWS_END }
#define ROPE_TABS(TAB, LD, FOFF) f32x4 t0_[4], t1_[4]; _Pragma("unroll") for (int m = 0; m < 4; ++m) { const float* tp_ = (TAB) + (unsigned)(row0 + ai * 128 + m * 16) * (unsigned)(LD) + (unsigned)(FOFF); t0_[m] = *(const f32x4*)tp_; t1_[m] = *(const f32x4*)(tp_ + 4); }

DI u32x4 pack8u(const f32x4& a, const f32x4& b) { u32x4 w; w.x = cvt_pk_bf16(a[0], a[1]); w.y = cvt_pk_bf16(a[2], a[3]); w.z = cvt_pk_bf16(b[0], b[1]); w.w = cvt_pk_bf16(b[2], b[3]); return w; }
struct EpiAMain {
    static constexpr bool PERM = true, AFTER_DRAIN = false;
    bf16_t* qcat; bf16_t* gate; bf16_t* keys; float* ckv; const float* ropeA; const float* gkv; LAS float* part;
    DI void operator()(const f32x4 (&acc)[2][2][4][2], const Unit& u, int wr, int wc, int fr, int fq) const {
        const int row0 = u.pm * 256 + wr * 64 + fr; const float qs = 0.07905694150420949f * 1.4426950408889634f;
        if (u.pn < 8) {
            EPI_ROWS_BEGIN
#pragma unroll
                for (int bj = 0; bj < 2; ++bj)
                    *(u32x4*)(qcat + (unsigned)row * 2560 + (2 * u.pn + bj) * 160 + 32 * wc + 8 * fq) = pack8u(acc[ai][bj][m][0] * qs, acc[ai][bj][m][1] * qs);
            EPI_ROWS_END
        } else if (u.pn < 10) {
#pragma unroll
            for (int ai = 0; ai < 2; ++ai) { ROPE_TABS(ropeA, 32, 8 * fq)
#pragma unroll
                for (int m = 0; m < 4; ++m) { const int row = row0 + ai * 128 + m * 16;
#pragma unroll
                    for (int bj = 0; bj < 2; ++bj) { f32x4 o1, o2; rope4(acc[ai][bj][m][0], acc[ai][bj][m][1], t0_[m], t1_[m], qs, o1, o2);
                        *(u32x4*)(qcat + (unsigned)row * 2560 + (8 * (u.pn - 8) + 4 * bj + wc) * 160 + 128 + 8 * fq) = pack8u(o1, o2); } } }
        } else if (u.pn < 18) {
            EPI_ROWS_BEGIN
#pragma unroll
                for (int bj = 0; bj < 2; ++bj) { f32x4 v0 = acc[ai][bj][m][0], v1 = acc[ai][bj][m][1];
#pragma unroll
                    for (int j = 0; j < 4; ++j) { v0[j] = silu_f(v0[j]); v1[j] = silu_f(v1[j]); }
                    *(u32x4*)(gate + (unsigned)row * 2048 + 256 * (u.pn - 10) + 128 * bj + 32 * wc + 8 * fq) = pack8u(v0, v1); }
            EPI_ROWS_END
        } else {
            const int rl0 = wr * 64 + fr;
#pragma unroll
            for (int ai = 0; ai < 2; ++ai)
#pragma unroll
                for (int m = 0; m < 4; ++m) { const f32x4 a0 = acc[ai][0][m][0], a1 = acc[ai][0][m][1];
                    const float t = xrow_sum(((a0[0] * a0[0] + a0[1] * a0[1]) + (a0[2] * a0[2] + a0[3] * a0[3])) + ((a1[0] * a1[0] + a1[1] * a1[1]) + (a1[2] * a1[2] + a1[3] * a1[3])));
                    if (fq == 0) part[(rl0 + ai * 128 + m * 16) * 4 + wc] = t; }
            asm volatile("s_waitcnt lgkmcnt(0)" ::: "memory"); __builtin_amdgcn_s_barrier(); asm volatile("" ::: "memory");
            const f32x4 g0 = *(const f32x4*)(gkv + 32 * wc + 8 * fq), g1 = *(const f32x4*)(gkv + 32 * wc + 8 * fq + 4);
#pragma unroll
            for (int ai = 0; ai < 2; ++ai) { ROPE_TABS(ropeA, 32, 8 * fq)
#pragma unroll
                for (int m = 0; m < 4; ++m) { const int row = row0 + ai * 128 + m * 16;
                    const f32x4 pq = *(const LAS f32x4*)(part + (rl0 + ai * 128 + m * 16) * 4);
                    const float rstd = 1.0f / sqrtf(((pq[0] + pq[1]) + (pq[2] + pq[3])) * (1.0f / 128) + EPS);
                    *(u32x4*)(keys + (unsigned)row * KROW + 32 * wc + 8 * fq) = pack8u(acc[ai][0][m][0] * rstd * g0, acc[ai][0][m][1] * rstd * g1);
                    if (wc == 0) { f32x4 o1, o2; rope4(acc[ai][1][m][0], acc[ai][1][m][1], t0_[m], t1_[m], 1.0f, o1, o2);
                        *(u32x4*)(keys + (unsigned)row * KROW + 128 + 8 * fq) = pack8u(o1, o2); } } }
        }
    }
};
DI void store_hilo8(bf16_t* dst, const f32x4& a, const f32x4& b) {
    const u32x4 h = pack8u(a, b); const f32x4 ra = a - (f32x4){bflo(h.x), bfhi(h.x), bflo(h.y), bfhi(h.y)}, rb = b - (f32x4){bflo(h.z), bfhi(h.z), bflo(h.w), bfhi(h.w)};
    *(u32x4*)dst = h; *(u32x4*)(dst + 64) = pack8u(ra, rb);
}
struct EpiAIdx {
    static constexpr bool PERM = true, AFTER_DRAIN = false;
    bf16_t* qidx; bf16_t* kidx; float* widx; const float* ropeI;
    DI void operator()(const f32x4 (&acc)[2][2][4][2], const Unit& u, int wr, int wc, int fr, int fq) const {
        const int row0 = u.pm * 256 + wr * 64 + fr; const int a = wc & 1;
#pragma unroll
        for (int ai = 0; ai < 2; ++ai) { ROPE_TABS(ropeI, 64, 2 * (16 * a + 4 * fq))
#pragma unroll
            for (int m = 0; m < 4; ++m) { const int row = row0 + ai * 128 + m * 16;
                if (u.pn < 2) {
#pragma unroll
                    for (int bj = 0; bj < 2; ++bj) { f32x4 o1, o2; rope4(acc[ai][bj][m][0], acc[ai][bj][m][1], t0_[m], t1_[m], 1.0f, o1, o2);
                        store_hilo8(qidx + (unsigned)row * 1024 + (4 * u.pn + 2 * bj + (wc >> 1)) * 128 + 32 * a + 8 * fq, o1, o2); }
                } else {
                    if (wc < 2) { f32x4 o1, o2; rope4(acc[ai][0][m][0], acc[ai][0][m][1], t0_[m], t1_[m], 1.0f, o1, o2);
                        store_hilo8(kidx + (unsigned)row * 128 + 32 * a + 8 * fq, o1, o2); }
                    if (wc == 2 && fq == 0) { *(f32x4*)(widx + (unsigned)row * 8) = acc[ai][0][m][0] * 0.35355339059327373f; *(f32x4*)(widx + (unsigned)row * 8 + 4) = acc[ai][0][m][1] * 0.35355339059327373f; }
                } } }
    }
};
struct EpiUV {
    static constexpr bool PERM = true, AFTER_DRAIN = false;
    bf16_t* gate;
    DI void operator()(const f32x4 (&acc)[2][2][4][2], const Unit& u, int wr, int wc, int fr, int fq) const {
        const int row0 = u.pm * 256 + wr * 64 + fr;
#pragma unroll
        for (int ai = 0; ai < 2; ++ai) {
            u32x4 gq[4][2];
#pragma unroll
            for (int m = 0; m < 4; ++m)
#pragma unroll
                for (int bj = 0; bj < 2; ++bj) gq[m][bj] = *(const u32x4*)(gate + (unsigned)(row0 + ai * 128 + m * 16) * 2048 + 256 * u.pn + 128 * bj + 32 * wc + 8 * fq);
#pragma unroll
            for (int m = 0; m < 4; ++m)
#pragma unroll
                for (int bj = 0; bj < 2; ++bj) { const u32x4 g = gq[m][bj];
                    *(u32x4*)(gate + (unsigned)(row0 + ai * 128 + m * 16) * 2048 + 256 * u.pn + 128 * bj + 32 * wc + 8 * fq) =
                        pack8u(acc[ai][bj][m][0] * (f32x4){bflo(g.x), bfhi(g.x), bflo(g.y), bfhi(g.y)}, acc[ai][bj][m][1] * (f32x4){bflo(g.z), bfhi(g.z), bflo(g.w), bfhi(g.w)}); }
        }
    }
};
struct EpiRes {
    static constexpr bool PERM = false, AFTER_DRAIN = false;
    const float* base; float* out; const float* mgate;
    DI void operator()(const f32x4 (&acc)[2][2][4][2], const Unit& u, int wr, int wc, int fr, int fq) const {
        const int row0 = u.pm * 256 + wr * 64 + fr; const float* mg = mgate + (size_t)(u.pm >> 4) * 3072;
#pragma unroll
        for (int bj = 0; bj < 2; ++bj) {
            f32x4 gv[2];
#pragma unroll
            for (int n = 0; n < 2; ++n) gv[n] = *(const f32x4*)(mg + 256 * u.pn + 128 * bj + 32 * wc + 16 * n + 4 * fq);
#pragma unroll
            for (int ai = 0; ai < 2; ++ai) {
                f32x4 bs[4][2];
#pragma unroll
                for (int m = 0; m < 4; ++m)
#pragma unroll
                    for (int n = 0; n < 2; ++n) bs[m][n] = *(const f32x4*)(base + (unsigned)(row0 + ai * 128 + m * 16) * 1024 + 256 * u.pn + 128 * bj + 32 * wc + 16 * n + 4 * fq);
#pragma unroll
                for (int m = 0; m < 4; ++m)
#pragma unroll
                    for (int n = 0; n < 2; ++n) *(f32x4*)(out + (unsigned)(row0 + ai * 128 + m * 16) * 1024 + 256 * u.pn + 128 * bj + 32 * wc + 16 * n + 4 * fq) = bs[m][n] + gv[n] * acc[ai][bj][m][n];
            }
        }
    }
};
struct EpiKV {
    static constexpr bool PERM = true, AFTER_DRAIN = false;
    bf16_t* kb; bf16_t* vb; const float* ropeB;
    DI void operator()(const f32x4 (&acc)[2][2][4][2], const Unit& u, int wr, int wc, int fr, int fq) const {
        const int row0 = u.pm * 256 + wr * 64 + fr;
        if (u.pn < 4) {
#pragma unroll
            for (int ai = 0; ai < 2; ++ai) { ROPE_TABS(ropeB, 128, 2 * (16 * wc + 4 * fq))
#pragma unroll
                for (int m = 0; m < 4; ++m) { const int row = row0 + ai * 128 + m * 16;
#pragma unroll
                    for (int bj = 0; bj < 2; ++bj) { f32x4 o1, o2; rope4(acc[ai][bj][m][0], acc[ai][bj][m][1], t0_[m], t1_[m], 1.0f, o1, o2);
                        *(u32x4*)(kb + (unsigned)row * 1024 + 256 * u.pn + 128 * bj + 32 * wc + 8 * fq) = pack8u(o1, o2); } } }
        } else {
            EPI_ROWS_BEGIN
#pragma unroll
                for (int bj = 0; bj < 2; ++bj)
                    *(u32x4*)(vb + (unsigned)row * 1024 + 256 * (u.pn - 4) + 128 * bj + 32 * wc + 8 * fq) = pack8u(acc[ai][bj][m][0], acc[ai][bj][m][1]);
            EPI_ROWS_END
        }
    }
};
struct EpiBIn {
    static constexpr bool PERM = true, AFTER_DRAIN = false;
    bf16_t* q3; bf16_t* gb; const float* ropeB;
    DI void operator()(const f32x4 (&acc)[2][2][4][2], const Unit& u, int wr, int wc, int fr, int fq) const {
        const int row0 = u.pm * 256 + wr * 64 + fr;
        if (u.pn < 12) {
            bf16_t* qg = q3 + (size_t)(u.pn >> 2) * M * 1024;
#pragma unroll
            for (int ai = 0; ai < 2; ++ai) { ROPE_TABS(ropeB, 128, 2 * (16 * wc + 4 * fq))
#pragma unroll
                for (int m = 0; m < 4; ++m) { const int row = row0 + ai * 128 + m * 16;
#pragma unroll
                    for (int bj = 0; bj < 2; ++bj) { f32x4 o1, o2; rope4(acc[ai][bj][m][0], acc[ai][bj][m][1], t0_[m], t1_[m], 0.08838834764831845f, o1, o2);
                        *(u32x4*)(qg + (unsigned)row * 1024 + 256 * (u.pn & 3) + 128 * bj + 32 * wc + 8 * fq) = pack8u(o1, o2); } } }
        } else {
            EPI_ROWS_BEGIN
#pragma unroll
                for (int bj = 0; bj < 2; ++bj)
                { f32x4 v0 = acc[ai][bj][m][0], v1 = acc[ai][bj][m][1];
#pragma unroll
                    for (int j = 0; j < 4; ++j) { v0[j] = silu_f(v0[j]); v1[j] = silu_f(v1[j]); }
                    *(u32x4*)(gb + (unsigned)row * 1024 + 256 * (u.pn - 12) + 128 * bj + 32 * wc + 8 * fq) = pack8u(v0, v1); }
            EPI_ROWS_END
        }
    }
};

DI int map_src_col(int mat, int n) {
    switch (mat) {
    case 0:
        if (n < 2048) return n;
        if (n < 2560) { const int p = n & 31; return (n & ~31) + 16 * ((p >> 2) & 1) + 4 * (p >> 3) + (p & 3); }
        if (n < 4608) return 2720 + (n - 2560);
        if (n < 4736) return 2560 + (n - 4608);
        if (n < 4768) { const int p = n - 4736; return 2688 + 16 * ((p >> 2) & 1) + 4 * (p >> 3) + (p & 3); }
        return -1;
    case 1:
        if (n < 576) { const int hd = n >> 6, p = n & 63, a = p >> 5, fq = (p >> 3) & 3, nn = (p >> 2) & 1, j = p & 3; return 4768 + hd * 64 + nn * 32 + a * 16 + 4 * fq + j; }
        if (n < 584) return 5344 + (n - 576);
        return -1;
    case 3: case 4: {
        const int lim = (mat == 3) ? 1024 : 3072;
        if (n < lim) { const int hd = n >> 7, p = n & 127, a = p >> 5, fq = (p >> 3) & 3, nn = (p >> 2) & 1, j = p & 3; return hd * 128 + nn * 64 + a * 16 + 4 * fq + j; }
        return n; }
    default: return n;
    }
}
DI void transpose_tile(const float* W, int ldw, int k0, int srccol, bf16_t* dst  , int ldk, bool split, LAS float* scr, int lane) {
#pragma unroll 8
    for (int i = 0; i < 32; ++i) { const int kk = 2 * i + (lane >> 5); scr[kk * 33 + (lane & 31)] = srccol >= 0 ? W[(size_t)(k0 + kk) * ldw + srccol] : 0.0f; }
    WAVE_LDS_FENCE();
    const int c = lane & 7;
#pragma unroll
    for (int j = 0; j < 4; ++j) { const int n = (lane >> 3) + 8 * j; const LAS float* s = scr + (8 * c) * 33 + n;
        float v[8];
#pragma unroll
        for (int e = 0; e < 8; ++e) v[e] = s[e * 33];
        u32x4 h; h.x = cvt_pk_bf16(v[0], v[1]); h.y = cvt_pk_bf16(v[2], v[3]); h.z = cvt_pk_bf16(v[4], v[5]); h.w = cvt_pk_bf16(v[6], v[7]);
        *(u32x4*)(dst + (size_t)n * ldk + 8 * c) = h;
        if (split) { u32x4 l; l.x = cvt_pk_bf16(v[0] - bflo(h.x), v[1] - bfhi(h.x)); l.y = cvt_pk_bf16(v[2] - bflo(h.y), v[3] - bfhi(h.y));
            l.z = cvt_pk_bf16(v[4] - bflo(h.z), v[5] - bfhi(h.z)); l.w = cvt_pk_bf16(v[6] - bflo(h.w), v[7] - bfhi(h.w));
            *(u32x4*)(dst + (size_t)n * ldk + 1024 + 8 * c) = l; } }
    WAVE_LDS_FENCE();
}
DI double ipow(double base, int e) { double r = 1.0, b = base; for (int i = 0; i < 6; ++i) { if (e & 1) r *= b; b *= b; e >>= 1; } return r; }
DI void phase0(const Params& p, LAS unsigned char* lds, int tid, int wave, int lane) {
    unsigned char* ws = p.ws;
    const int G = gridDim.x, NW = G * 8, gw = wave * G + blockIdx.x;
    LAS float* sc = (LAS float*)lds;
    LAS float* scr = (LAS float*)(lds + 65536 + wave * 8448);
    {
        for (int i = tid; i < NB * D; i += 512) { const int b = i >> 10, k = i & 1023; sc[k * 16 + b] = silu_f(p.in[1][i]); }
        __syncthreads();
    }
    constexpr int I_MOD = 384, I0 = 16 * 152, I1 = 16 * 24, I2 = 32 * 32, I3 = 16 * 64, I4 = 16 * 128, I5 = 16 * 32, I6 = 128;
    constexpr int NITEMS = I_MOD + I0 + I1 + I2 + I3 + I4 + I5 + I6;
    for (int it = gw; it < NITEMS; it += NW) {
        int r = it;
        if (r < I_MOD) {
            const int layer = r / 192, cgp = r % 192, col = cgp * 16 + (lane & 15), kp = lane >> 4;
            const float* Wm = p.in[layer ? 13 : 4]; const float* bias = p.in[layer ? 14 : 5];
            float acc[16];
#pragma unroll
            for (int b = 0; b < 16; ++b) acc[b] = 0.f;
#pragma unroll 8
            for (int k = kp * 256; k < kp * 256 + 256; ++k) { const float w = Wm[(size_t)k * 3072 + col];
                const f32x4 s0 = *(const LAS f32x4*)(sc + k * 16), s1 = *(const LAS f32x4*)(sc + k * 16 + 4), s2 = *(const LAS f32x4*)(sc + k * 16 + 8), s3 = *(const LAS f32x4*)(sc + k * 16 + 12);
#pragma unroll
                for (int j = 0; j < 4; ++j) { acc[j] += s0[j] * w; acc[4 + j] += s1[j] * w; acc[8 + j] += s2[j] * w; acc[12 + j] += s3[j] * w; } }
#pragma unroll
            for (int b = 0; b < 16; ++b) { acc[b] += __shfl_xor(acc[b], 16); acc[b] += __shfl_xor(acc[b], 32); }
            if (kp == 0) { float* mod = (float*)(ws + OFF_MOD) + (size_t)layer * NB * 3072; const float bv = bias[col];
#pragma unroll
                for (int b = 0; b < 16; ++b) mod[b * 3072 + col] = acc[b] + bv; }
            continue;
        }
        r -= I_MOD;
        int mat, K, ldw, ldk; const float* W; bf16_t* WT; bool split = false;
        if (r < I0) { mat = 0; W = p.in[6]; ldw = 5352; K = 1024; ldk = 1024; WT = (bf16_t*)(ws + OFF_WA_MAIN); }
        else if ((r -= I0) < I1) { mat = 1; W = p.in[6]; ldw = 5352; K = 1024; ldk = 2048; WT = (bf16_t*)(ws + OFF_WA_IDX); split = true; }
        else if ((r -= I1) < I2) { mat = 2; W = p.in[9]; ldw = 1024; K = 2048; ldk = 2048; WT = (bf16_t*)(ws + OFF_WAO); }
        else if ((r -= I2) < I3) { mat = 3; W = p.in[11]; ldw = 2048; K = 1024; ldk = 1024; WT = (bf16_t*)(ws + OFF_WKV); }
        else if ((r -= I3) < I4) { mat = 4; W = p.in[15]; ldw = 4096; K = 1024; ldk = 1024; WT = (bf16_t*)(ws + OFF_WBI); }
        else if ((r -= I4) < I5) { mat = 5; W = p.in[16]; ldw = 1024; K = 1024; ldk = 1024; WT = (bf16_t*)(ws + OFF_WBO); }
        else { r -= I5; mat = 6; W = nullptr; ldw = 128; K = 128; ldk = 256; WT = (bf16_t*)(ws + OFF_WUV); }
        if (mat < 6) {
            const int nkb = K / 64, kb = r % nkb, nb = r / nkb, n0 = nb * 32, k0 = kb * 64;
            const int srccol = map_src_col(mat, n0 + (lane & 31));
            transpose_tile(W, ldw, k0, srccol, WT + (size_t)n0 * ldk + k0, ldk, split, scr, lane);
        } else {
            const int h = r >> 3, cb = (r >> 2) & 1, vb = r & 3;
            bf16_t* dst = WT + (size_t)(h * 128 + vb * 32) * 256 + (h & 1) * 128 + cb * 64;
            transpose_tile(p.in[8] + (size_t)h * 16384, 128, cb * 64, vb * 32 + (lane & 31), dst, 256, false, scr, lane);
            bf16_t* dz = WT + (size_t)(h * 128 + vb * 32) * 256 + (1 - (h & 1)) * 128 + cb * 64;
            const int c = lane & 7;
#pragma unroll
            for (int j = 0; j < 4; ++j) { const int n = (lane >> 3) + 8 * j; *(u32x4*)(dz + (size_t)n * 256 + 8 * c) = (u32x4){0u, 0u, 0u, 0u}; }
        }
    }
    const int* pos = (const int*)p.in[2];
    for (size_t idx = (size_t)blockIdx.x * 512 + tid; idx < (size_t)M * 112; idx += (size_t)G * 512) {
        const int tok = (int)(idx / 112), e = (int)(idx % 112);
        double base; int f; float* dst;
        if (e < 16) { base = 0.5623413251903491; f = e; dst = (float*)(ws + OFF_ROPE_A) + ((size_t)tok * 16 + f) * 2; }
        else if (e < 48) { base = 0.7498942093324559; f = e - 16; dst = (float*)(ws + OFF_ROPE_I) + ((size_t)tok * 32 + f) * 2; }
        else { base = 0.8659643233600653; f = e - 48; dst = (float*)(ws + OFF_ROPE_B) + ((size_t)tok * 64 + f) * 2; }
        const double ang = (double)pos[tok] * ipow(base, f);
        const double kq = __builtin_rint(ang * 0.6366197723675814);
        double rr = __builtin_fma(-kq, 1.5707963267948966, ang); rr = __builtin_fma(-kq, 6.123233995736766e-17, rr);
        const double r2 = rr * rr;
        double sn = rr * (1.0 + r2 * (-1.0 / 6 + r2 * (1.0 / 120 + r2 * (-1.0 / 5040 + r2 * (1.0 / 362880 + r2 * (-1.0 / 39916800 + r2 * (1.0 / 6227020800.0)))))));
        double cs = 1.0 + r2 * (-0.5 + r2 * (1.0 / 24 + r2 * (-1.0 / 720 + r2 * (1.0 / 40320 + r2 * (-1.0 / 3628800 + r2 * (1.0 / 479001600.0 + r2 * (-1.0 / 87178291200.0)))))));
        const int q = (int)((long long)kq & 3);
        double co, si;
        if (q == 0) { co = cs; si = sn; } else if (q == 1) { co = -sn; si = cs; } else if (q == 2) { co = -cs; si = -sn; } else { co = sn; si = -cs; }
        *(f32x2*)dst = (f32x2){(float)co, (float)si};
    }
}

DI float row_ss(const f32x4 (&v)[4]) { float ss = 0.f;
#pragma unroll
    for (int j = 0; j < 4; ++j) ss += (v[j][0] * v[j][0] + v[j][1] * v[j][1]) + (v[j][2] * v[j][2] + v[j][3] * v[j][3]);
    return ss; }
DI void phase_hnA(const Params& p, int wave, int lane) {
    const int NW = gridDim.x * 8, gw = blockIdx.x * 8 + wave;
    const float* x = p.in[0]; const float* g = p.in[3]; const float* mod = (const float*)(p.ws + OFF_MOD);
    bf16_t* HN = (bf16_t*)p.out;
#pragma unroll 1
    for (int row0 = gw * 4; row0 < M; row0 += NW * 4) {
        const int b = row0 >> 12;
        f32x4 v[4][4]; float rstd[4];
#pragma unroll
        for (int r = 0; r < 4; ++r)
#pragma unroll
            for (int j = 0; j < 4; ++j) v[r][j] = *((const f32x4*)(x + (size_t)(row0 + r) * 1024) + lane + 64 * j);
#pragma unroll
        for (int r = 0; r < 4; ++r) rstd[r] = 1.0f / sqrtf(wave_sum(row_ss(v[r])) * (1.0f / 1024) + EPS);
#pragma unroll
        for (int j = 0; j < 4; ++j) { const int col = 256 * j + 4 * lane;
            const f32x4 gv = *(const f32x4*)(g + col), sh = *(const f32x4*)(mod + (size_t)b * 3072 + col), scv = *(const f32x4*)(mod + (size_t)b * 3072 + 1024 + col);
            const f32x4 gs = gv * (scv + 1.0f);
#pragma unroll
            for (int r = 0; r < 4; ++r) { const f32x4 y = (v[r][j] * rstd[r]) * gs + sh;
                const u32x2 h = pack4(y); const f32x4 rem = y - unpack4(h);
                *(u32x2*)(HN + (size_t)(row0 + r) * 2048 + col) = h; *(u32x2*)(HN + (size_t)(row0 + r) * 2048 + 1024 + col) = pack4(rem); } }
    }
}
DI void phase_ckv(const Params& p, int wave, int lane) {
    const int NW = gridDim.x * 8, gw = blockIdx.x * 8 + wave;
    const float* ckv = (const float*)(p.ws + OFF_CKV); bf16_t* keys = (bf16_t*)(p.ws + OFF_KEYS); const float* g = p.in[7];
    const f32x2 gv = *(const f32x2*)(g + 2 * lane);
    for (int row = gw; row < M; row += NW) {
        const f32x2 v = *(const f32x2*)(ckv + (size_t)row * 128 + 2 * lane);
        const float rstd = 1.0f / sqrtf(wave_sum(v[0] * v[0] + v[1] * v[1]) * (1.0f / 128) + EPS);
        *(unsigned*)(keys + (size_t)row * KROW + 2 * lane) = cvt_pk_bf16(v[0] * rstd * gv[0], v[1] * rstd * gv[1]);
    }
}

#define MFMA32(a, b, c) __builtin_amdgcn_mfma_f32_32x32x16_bf16((a), (b), (c), 0, 0, 0)
#define MFMA16(a, b, c) __builtin_amdgcn_mfma_f32_16x16x32_bf16((a), (b), (c), 0, 0, 0)
DI bf16x8 pack8(const f32x4& a, const f32x4& b) { u32x4 w; w.x = cvt_pk_bf16(a[0], a[1]); w.y = cvt_pk_bf16(a[2], a[3]); w.z = cvt_pk_bf16(b[0], b[1]); w.w = cvt_pk_bf16(b[2], b[3]); return __builtin_bit_cast(bf16x8, w); }
DI bf16x8 ident_frag(int lane, int half) {
    const int n = lane & 15, g = lane >> 4; u32x4 w = {0u, 0u, 0u, 0u};
    if (g == 2 * half + (n >> 3)) { const int jj = n & 7; const unsigned one = (jj & 1) ? 0x3F800000u : 0x00003F80u;
        if ((jj >> 1) == 0) w.x = one; else if ((jj >> 1) == 1) w.y = one; else if ((jj >> 1) == 2) w.z = one; else w.w = one; }
    return __builtin_bit_cast(bf16x8, w);
}
DI unsigned mbcnt64(unsigned long long m) { return __builtin_amdgcn_mbcnt_hi((unsigned)(m >> 32), __builtin_amdgcn_mbcnt_lo((unsigned)m, 0u)); }


DI int wave_sum_dpp(int v) {
    v += __builtin_amdgcn_update_dpp(0, v, 0x111, 0xf, 0xf, true);
    v += __builtin_amdgcn_update_dpp(0, v, 0x112, 0xf, 0xf, true);
    v += __builtin_amdgcn_update_dpp(0, v, 0x114, 0xf, 0xf, true);
    v += __builtin_amdgcn_update_dpp(0, v, 0x118, 0xf, 0xf, true);
    v += __builtin_amdgcn_update_dpp(0, v, 0x142, 0xa, 0xf, false);
    v += __builtin_amdgcn_update_dpp(0, v, 0x143, 0xc, 0xf, false);
    return __builtin_amdgcn_readlane(v, 63);
}
template <int J>
DI void dsa_select(const float* scq, const int N, const int lv, LAS int* sel) {
    unsigned u[J];
#pragma unroll
    for (int j = 0; j < J; ++j) { unsigned bits = __float_as_uint(__hip_atomic_load(scq + j * 64 + lv, __ATOMIC_RELAXED, __HIP_MEMORY_SCOPE_AGENT)); if (bits == 0x80000000u) bits = 0u;
        const unsigned o = bits ^ ((bits >> 31) ? 0xFFFFFFFFu : 0x80000000u); u[j] = (lv < N - j * 64) ? o : 0u; }
    unsigned T = 0u; int A = J * 64, B = 0; int bit = 31;
#pragma unroll 1
    for (; bit >= 0; --bit) {
        if (A - B <= 64 && bit < 31) break;
        const unsigned cand = T | (1u << bit); int cl = 0;
#pragma unroll
        for (int j = 0; j < J; ++j) cl += (u[j] >= cand) ? 1 : 0;
        const int C = wave_sum_dpp(cl);
        if (C >= 256) { T = cand; A = C; } else B = C;
    }
    if (bit >= 0) {
        const int sh = bit + 1; int nb = 0;
#pragma unroll
        for (int j = 0; j < J; ++j) { const bool und = ((u[j] ^ T) >> sh) == 0u; const unsigned long long um = __ballot(und);
            const int slot = (int)__builtin_amdgcn_mbcnt_hi((unsigned)(um >> 32), __builtin_amdgcn_mbcnt_lo((unsigned)um, (unsigned)nb));
            sel[und ? slot : 256 + lv] = (int)u[j]; nb += __popcll(um); }
        WAVE_LDS_FENCE();
        const unsigned w = (lv < nb) ? (unsigned)sel[lv] : 0u;
        WAVE_LDS_FENCE();
        const int B0 = B;
#pragma unroll 1
        for (; bit >= 0; --bit) { const unsigned cand = T | (1u << bit); const int C = B0 + __popcll(__ballot(w >= cand)); if (C >= 256) T = cand; else B = C; }
    }
    int base = 0;
#pragma unroll
    for (int j = 0; j < J; ++j) { const bool gt = u[j] > T; const unsigned long long gm = __ballot(gt);
        const int slot = (int)__builtin_amdgcn_mbcnt_hi((unsigned)(gm >> 32), __builtin_amdgcn_mbcnt_lo((unsigned)gm, (unsigned)base));
        sel[gt ? slot : 256 + lv] = j * 64 + lv; base += __popcll(gm); }
    int remaining = 256 - base;
#pragma unroll
    for (int j = 0; j < J; ++j) { const bool eq = u[j] == T; const unsigned long long em = __ballot(eq);
        if (em != 0ull && remaining > 0) { const int r = (int)mbcnt64(em); if (eq && r < remaining) sel[base + r] = j * 64 + lv;
            const int c = __popcll(em), tk = c < remaining ? c : remaining; base += tk; remaining -= tk; } }
}
DI void phase_dsa(const Params& p, LAS unsigned char* lds, int tid, int wave, int lane) {
    unsigned char* ws = p.ws;
    const bf16_t* QIDX = (const bf16_t*)(ws + OFF_QIDX); const bf16_t* KIDX = (const bf16_t*)(ws + OFF_KIDX); const float* WIDX = (const float*)(ws + OFF_WIDX);
    bf16_t* QCAT = (bf16_t*)(ws + OFF_QCAT); const bf16_t* KEYS = (const bf16_t*)(ws + OFF_KEYS);
    float* SC = (float*)(ws + OFF_SC) + (size_t)blockIdx.x * (32 * 4096);
    LAS unsigned char* Qs = lds; LAS int* sel = (LAS int*)(lds + 66048 + wave * 2048);
    const int G = gridDim.x;
#ifdef PROBE
    if (wave == 0 && lane == 0) { ((LAS unsigned*)(lds + 150000))[0] = 0u; ((LAS unsigned*)(lds + 150000))[1] = 0u; }
#endif
    const bf16x8 e0 = ident_frag(lane, 0), e1 = ident_frag(lane, 1);
    const float NEG_INF = -__builtin_huge_valf();
    for (int rd = 0;; ++rd) {
        int t;
        if (G == 256) {
            if (rd >= 8) break;
            const int j = (int)blockIdx.x >> 3, r4 = rd & 3, tt = r4 * 32 + ((r4 & 1) ? (31 - j) : j);
            t = (tt << 4) + ((int)blockIdx.x & 7) + 8 * (rd >> 2);
        } else { t = rd * G + ((rd & 1) ? (G - 1 - (int)blockIdx.x) : (int)blockIdx.x); if (t >= 2048) break; }
        int lo_ = lane; asm volatile("" : "+v"(lo_)); const int l31 = lo_ & 31, h2 = lo_ >> 5;
        const int qt = 127 - (t >> 4), b = t & 15, q0 = qt * 32; const size_t tok0 = (size_t)b * SEQ;
        int tid_ = tid; asm volatile("" : "+v"(tid_));
        for (int idx = tid_; idx < 32 * 128; idx += 512) { const int q = idx >> 7, ch = idx & 127;
            *(LAS u32x4*)(Qs + q * 2064 + ch * 16) = *(const u32x4*)(QIDX + (tok0 + q0 + q) * 1024 + ch * 8); }
        float wq[8];
        { const f32x4 w0 = *(const f32x4*)(WIDX + (tok0 + q0 + l31) * 8), w1 = *(const f32x4*)(WIDX + (tok0 + q0 + l31) * 8 + 4);
#pragma unroll
          for (int j = 0; j < 4; ++j) { wq[j] = w0[j]; wq[4 + j] = w1[j]; } }
        __syncthreads();
#ifndef DSA_NOSCORE
#ifdef DSA_REP_SCORE
        for (int rep_ = 0; rep_ < 2; ++rep_)
#endif
        for (int kt = wave; kt <= qt; kt += 8) {
            const bf16_t* kp = KIDX + (tok0 + kt * 32 + l31) * 128 + 8 * h2;
            bf16x8 Ah[4], Al[4];
#pragma unroll
            for (int kc = 0; kc < 4; ++kc) { Ah[kc] = *(const bf16x8*)(kp + 16 * kc); Al[kc] = *(const bf16x8*)(kp + 64 + 16 * kc); }
            f32x16 s;
#pragma unroll
            for (int i = 0; i < 16; ++i) s[i] = 0.f;
#pragma unroll
            for (int h = 0; h < 8; ++h) {
                f32x16 acc;
#pragma unroll
                for (int i = 0; i < 16; ++i) acc[i] = 0.f;
#pragma unroll
                for (int kc = 0; kc < 4; ++kc) {
                    const bf16x8 Bh = *(const LAS bf16x8*)(Qs + l31 * 2064 + h * 256 + (16 * kc + 8 * h2) * 2);
                    const bf16x8 Bl = *(const LAS bf16x8*)(Qs + l31 * 2064 + h * 256 + 128 + (16 * kc + 8 * h2) * 2);
                    acc = MFMA32(Ah[kc], Bh, acc); acc = MFMA32(Al[kc], Bh, acc); acc = MFMA32(Ah[kc], Bl, acc);
                }
#pragma unroll
                for (int i = 0; i < 16; ++i) s[i] += wq[h] * fmaxf(acc[i], 0.f);
                asm volatile("" ::: "memory");
            }
            float* dst = SC + (size_t)l31 * 4096 + kt * 32 + 4 * h2;
#pragma unroll
            for (int jj = 0; jj < 4; ++jj) *(f32x4*)(dst + 8 * jj) = (f32x4){s[4 * jj], s[4 * jj + 1], s[4 * jj + 2], s[4 * jj + 3]};
        }
#endif
        asm volatile("s_waitcnt vmcnt(0)" ::: "memory");
        __syncthreads();
#ifdef PROBE
        unsigned long long pt0_ = __builtin_amdgcn_s_memrealtime();
#endif
#pragma unroll 1
        for (int qi = 0; qi < 4; ++qi) {
            const int ql = wave * 4 + qi, spos = q0 + ql, N = spos + 1; const size_t tok = tok0 + spos;
            int lv = lane; asm volatile("" : "+v"(lv)); const int ln = lv & 15, g4 = lv >> 4;
            int nvalid;
            if (N <= 256) {
                nvalid = N;
#pragma unroll
                for (int j = 0; j < 4; ++j) { const int k = j * 64 + lv; sel[k] = k < N ? k : 0; }
            } else {
                nvalid = 256;
#ifndef DSA_NOSEL
                const float* scq = SC + (size_t)ql * 4096;
                if (N <= 1024) dsa_select<16>(scq, N, lv, sel);
                else if (N <= 2048) dsa_select<32>(scq, N, lv, sel);
                else if (N <= 3072) dsa_select<48>(scq, N, lv, sel);
                else dsa_select<64>(scq, N, lv, sel);
#endif
            }
            WAVE_LDS_FENCE();
#ifdef PROBE
            { const unsigned long long t1_ = __builtin_amdgcn_s_memrealtime(); if (blockIdx.x == PROBE_BLK && wave == 0 && lane == 0) ((LAS unsigned*)(lds + 150000))[0] += (unsigned)(t1_ - pt0_); pt0_ = t1_; }
#endif
#ifdef DBG_DSA
            { float* dbg = p.out + tok * 1024;
#pragma unroll
              for (int j = 0; j < 4; ++j) dbg[j * 64 + lv] = (float)sel[j * 64 + lv];
              dbg[256 + lv] = (float)nvalid; }
#define DSA_NOATTN
#endif
#ifndef DSA_NOATTN
#ifndef DSA_REP_ATTN
#define DSA_REP_ATTN 1
#endif
#pragma unroll 1
            for (int rep_ = 0; rep_ < DSA_REP_ATTN; ++rep_) {
            const bf16_t* qp = QCAT + tok * 2560 + ln * 160 + 8 * g4;
            bf16x8 qf[5];
#pragma unroll
            for (int kc = 0; kc < 5; ++kc) qf[kc] = *(const bf16x8*)(qp + 32 * kc);
            const int npair = (nvalid + 31) >> 5;
            float m_run = NEG_INF, l_run = 0.f;
            f32x4 O[8];
#pragma unroll
            for (int d = 0; d < 8; ++d) O[d] = (f32x4){0.f, 0.f, 0.f, 0.f};
            bf16x8 f0[5], f1[5], n0[5], n1[5];
            { const bf16_t* kp0 = KEYS + (tok0 + sel[ln]) * KROW + 8 * g4; const bf16_t* kp1 = KEYS + (tok0 + sel[16 + ln]) * KROW + 8 * g4;
#pragma unroll
              for (int kc = 0; kc < 5; ++kc) { f0[kc] = *(const bf16x8*)(kp0 + 32 * kc); f1[kc] = *(const bf16x8*)(kp1 + 32 * kc); } }
            auto pair_body = [&](const bf16x8 (&c0)[5], const bf16x8 (&c1)[5], bf16x8 (&x0)[5], bf16x8 (&x1)[5], const int up) __attribute__((always_inline)) {
                if (up + 1 < npair) {
                    const bf16_t* kp0 = KEYS + (tok0 + sel[32 * up + 32 + ln]) * KROW + 8 * g4; const bf16_t* kp1 = KEYS + (tok0 + sel[32 * up + 48 + ln]) * KROW + 8 * g4;
#pragma unroll
                    for (int kc = 0; kc < 5; ++kc) { x0[kc] = *(const bf16x8*)(kp0 + 32 * kc); x1[kc] = *(const bf16x8*)(kp1 + 32 * kc); }
                }
                f32x4 s0 = {0.f, 0.f, 0.f, 0.f}, s1 = {0.f, 0.f, 0.f, 0.f};
#pragma unroll
                for (int kc = 0; kc < 5; ++kc) { s0 = MFMA16(c0[kc], qf[kc], s0); s1 = MFMA16(c1[kc], qf[kc], s1); }
                if (nvalid < 256) { const int sl = 32 * up + 4 * g4;
#pragma unroll
                    for (int i = 0; i < 4; ++i) { s0[i] = (sl + i < nvalid) ? s0[i] : NEG_INF; s1[i] = (sl + 16 + i < nvalid) ? s1[i] : NEG_INF; } }
                const float tm = xrow_max(fmaxf(fmaxf(fmaxf(s0[0], s0[1]), fmaxf(s0[2], s0[3])), fmaxf(fmaxf(s1[0], s1[1]), fmaxf(s1[2], s1[3]))));
                if (__ballot(tm > m_run) != 0ull) {
                    const float m_new = fmaxf(m_run, tm), alpha = __builtin_amdgcn_exp2f(m_run - m_new); m_run = m_new; l_run *= alpha;
#pragma unroll
                    for (int d = 0; d < 8; ++d) O[d] *= alpha;
                }
                float ps = 0.f;
#pragma unroll
                for (int i = 0; i < 4; ++i) { s0[i] = __builtin_amdgcn_exp2f(s0[i] - m_run); s1[i] = __builtin_amdgcn_exp2f(s1[i] - m_run); ps += s0[i] + s1[i]; }
                l_run += ps;
                const bf16x8 pa = pack8(s0, s1);
                const f32x4 z = {0.f, 0.f, 0.f, 0.f};
#pragma unroll
                for (int kc = 0; kc < 4; ++kc) {
                    const f32x4 a0 = MFMA16(c0[kc], e0, z), a1 = MFMA16(c1[kc], e0, z), b0 = MFMA16(c0[kc], e1, z), b1 = MFMA16(c1[kc], e1, z);
                    O[2 * kc] = MFMA16(pack8(a0, a1), pa, O[2 * kc]);
                    O[2 * kc + 1] = MFMA16(pack8(b0, b1), pa, O[2 * kc + 1]);
                }
            };
#pragma unroll 1
            for (int up = 0; up < npair; up += 2) {
                pair_body(f0, f1, n0, n1, up);
                if (up + 1 < npair) pair_body(n0, n1, f0, f1, up + 1);
            }
            l_run = xrow_sum(l_run);
            { const float inv = 1.0f / l_run;
              bf16_t* op = ((rep_ == DSA_REP_ATTN - 1) ? QCAT + tok * 2560 : (bf16_t*)(SC + (size_t)ql * 4096)) + ln * 128 + 4 * g4;
#pragma unroll
              for (int d = 0; d < 8; ++d) *(u32x2*)(op + 16 * d) = pack4(O[d] * inv); }
            }
#endif
            WAVE_LDS_FENCE();
#ifdef PROBE
            { const unsigned long long t1_ = __builtin_amdgcn_s_memrealtime(); if (blockIdx.x == PROBE_BLK && wave == 0 && lane == 0) ((LAS unsigned*)(lds + 150000))[1] += (unsigned)(t1_ - pt0_); pt0_ = t1_; }
#endif
        }
        __syncthreads();
    }
#ifdef PROBE
    if (blockIdx.x == PROBE_BLK && wave == 0 && lane == 0) { unsigned* st = (unsigned*)(p.ws + OFF_BAR + 16384); st[0] = ((LAS unsigned*)(lds + 150000))[0]; st[1] = ((LAS unsigned*)(lds + 150000))[1]; }
#endif
}

DI void phase_normB(const Params& p, int wave, int lane) {
    const int NW = gridDim.x * 8, gw = blockIdx.x * 8 + wave;
    const float* h = p.out; const float* gk = p.in[10]; const float* gb = p.in[12]; const float* mod = (const float*)(p.ws + OFF_MOD) + (size_t)NB * 3072;
    bf16_t* HKV = (bf16_t*)(p.ws + OFF_HKV); bf16_t* HNB = (bf16_t*)(p.ws + OFF_HNB);
#pragma unroll 1
    for (int row0 = gw * 4; row0 < M; row0 += NW * 4) {
        const int b = row0 >> 12;
        f32x4 v[4][4]; float rstd[4];
#pragma unroll
        for (int r = 0; r < 4; ++r)
#pragma unroll
            for (int j = 0; j < 4; ++j) v[r][j] = *((const f32x4*)(h + (size_t)(row0 + r) * 1024) + lane + 64 * j);
#pragma unroll
        for (int r = 0; r < 4; ++r) rstd[r] = 1.0f / sqrtf(wave_sum(row_ss(v[r])) * (1.0f / 1024) + EPS);
#pragma unroll
        for (int j = 0; j < 4; ++j) { const int col = 256 * j + 4 * lane;
            const f32x4 g1 = *(const f32x4*)(gk + col), g2 = *(const f32x4*)(gb + col), sh = *(const f32x4*)(mod + (size_t)b * 3072 + col), scv = *(const f32x4*)(mod + (size_t)b * 3072 + 1024 + col);
            const f32x4 gs = g2 * (scv + 1.0f);
#pragma unroll
            for (int r = 0; r < 4; ++r) { const f32x4 nv = v[r][j] * rstd[r];
                *(u32x2*)(HKV + (size_t)(row0 + r) * 1024 + col) = pack4(nv * g1);
                *(u32x2*)(HNB + (size_t)(row0 + r) * 1024 + col) = pack4(nv * gs + sh); } }
    }
}

DI void phase_dil(const Params& p, LAS unsigned char* lds, int wave, int lane) {
    unsigned char* ws = p.ws;
    const bf16_t* KB = (const bf16_t*)(ws + OFF_KB); const bf16_t* VB = (const bf16_t*)(ws + OFF_VB); bf16_t* Q3 = (bf16_t*)(ws + OFF_Q3); float* LSE = (float*)(ws + OFF_LSE);
    LAS unsigned char* KL = lds; LAS unsigned char* VL = lds + 69632;
    const int G = gridDim.x, tid = wave * 64 + lane;
    const float NEG_INF = -__builtin_huge_valf();
    u32x4 kst[8], vst[8]; bf16x8 qst[4];
    int it = (G == 256) ? ((((int)blockIdx.x & 7) << 5) | ((int)blockIdx.x >> 3)) : (int)blockIdx.x;
#define DIL_DECODE(IT) const int blkres = (IT) & 31, head = ((IT) >> 5) & 7, r1_ = (IT) >> 8, grp = r1_ % 3, b = r1_ / 3; \
        const int lg = grp * 2, nblk = 32 >> lg, res = blkres >> (5 - lg), blk = blkres & (nblk - 1); const size_t tok0 = (size_t)b * SEQ;
#define DIL_LOAD(IT) do { DIL_DECODE(IT) \
        _Pragma("unroll") for (int i = 0; i < 8; ++i) { const int id = tid_ + 512 * i, row = id >> 4, ch = id & 15; const int ks = blk * 128 - 128 + row; \
            const size_t off = (tok0 + ((size_t)(ks < 0 ? 0 : ks) << lg) + res) * 1024 + head * 128 + ch * 8; \
            kst[i] = *(const u32x4*)(KB + off); vst[i] = *(const u32x4*)(VB + off); } \
        { const size_t tq_ = tok0 + ((size_t)(blk * 128 + wave * 16 + (tid_ & 15)) << lg) + res; const bf16_t* qp_ = Q3 + (size_t)grp * M * 1024 + tq_ * 1024 + head * 128 + 8 * ((tid_ >> 4) & 3); \
          _Pragma("unroll") for (int kc = 0; kc < 4; ++kc) qst[kc] = *(const bf16x8*)(qp_ + 32 * kc); } } while (0)
    { int tid_ = tid; asm volatile("" : "+v"(tid_)); if (it < 12288) DIL_LOAD(it); }
#pragma unroll 1
    for (; it < 12288; it += G) {
        int tid_ = tid; asm volatile("" : "+v"(tid_));
        const int ln = tid_ & 15, g4 = (tid_ >> 4) & 3;
#pragma unroll
        for (int i = 0; i < 8; ++i) { const int id = tid_ + 512 * i, row = id >> 4, ch = id & 15;
            *(LAS u32x4*)(KL + row * 272 + ch * 16) = kst[i]; *(LAS u32x4*)(VL + row * 288 + ch * 16) = vst[i]; }
        bf16x8 qf[4];
#pragma unroll
        for (int kc = 0; kc < 4; ++kc) qf[kc] = qst[kc];
        __syncthreads();
        if (it + G < 12288) DIL_LOAD(it + G);
        DIL_DECODE(it)
        const int qt = wave, qsub0 = blk * 128 + qt * 16;
        bf16_t* Qg = Q3 + (size_t)grp * M * 1024;
        const size_t tokq = tok0 + ((size_t)(qsub0 + ln) << lg) + res;
        f32x4 st[9];
#pragma unroll
        for (int tl = 0; tl < 9; ++tl) {
            const LAS unsigned char* kp = KL + (16 * (qt + tl) + ln) * 272 + 16 * g4;
            f32x4 acc = {0.f, 0.f, 0.f, 0.f};
#pragma unroll
            for (int kc = 0; kc < 4; ++kc) acc = MFMA16(*(const LAS bf16x8*)(kp + 64 * kc), qf[kc], acc);
#pragma unroll
            for (int i = 0; i < 4; ++i) { const int ksi = qsub0 - 128 + 16 * tl + 4 * g4 + i, dist = qsub0 + ln - ksi;
                st[tl][i] = (dist >= 0 && dist <= 128 && ksi >= 0) ? acc[i] : NEG_INF; }
        }
        float mx = NEG_INF;
#pragma unroll
        for (int tl = 0; tl < 9; ++tl) mx = fmaxf(fmaxf(fmaxf(st[tl][0], st[tl][1]), fmaxf(st[tl][2], st[tl][3])), mx);
        mx = fmaxf(mx, __shfl_xor(mx, 16)); mx = fmaxf(mx, __shfl_xor(mx, 32));
        float sum = 0.f;
#pragma unroll
        for (int tl = 0; tl < 9; ++tl)
#pragma unroll
            for (int i = 0; i < 4; ++i) { const float e = __expf(st[tl][i] - mx); st[tl][i] = e; sum += e; }
        sum += __shfl_xor(sum, 16); sum += __shfl_xor(sum, 32);
        const float inv = 1.0f / sum;
        if (g4 == 0) LSE[((size_t)grp * M + tokq) * 8 + head] = mx + __logf(sum);
        f32x4 O[8];
#pragma unroll
        for (int d = 0; d < 8; ++d) O[d] = (f32x4){0.f, 0.f, 0.f, 0.f};
#pragma unroll
        for (int up = 0; up < 5; ++up) {
            const int t0 = 2 * up, t1 = (2 * up + 1 < 9) ? 2 * up + 1 : 8;
            const LAS unsigned char* vp0 = VL + (16 * (qt + t0) + 4 * g4 + (ln >> 2)) * 288 + 8 * (ln & 3); const LAS unsigned char* vp1 = VL + (16 * (qt + t1) + 4 * g4 + (ln >> 2)) * 288 + 8 * (ln & 3);
            const f32x4 z = {0.f, 0.f, 0.f, 0.f};
            const bf16x8 pa = pack8(st[t0] * inv, (2 * up + 1 < 9) ? st[t1] * inv : z);
#pragma unroll
            for (int d = 0; d < 8; ++d) {
                const s16x4 lo = __builtin_amdgcn_ds_read_tr16_b64_v4i16((LAS s16x4*)(vp0 + 32 * d)), hi = __builtin_amdgcn_ds_read_tr16_b64_v4i16((LAS s16x4*)(vp1 + 32 * d));
                O[d] = MFMA16(__builtin_shufflevector(lo, hi, 0, 1, 2, 3, 4, 5, 6, 7), pa, O[d]);
            }
        }
        { bf16_t* op = Qg + tokq * 1024 + head * 128 + 4 * g4;
#pragma unroll
          for (int d = 0; d < 8; ++d) *(u32x2*)(op + 16 * d) = pack4(O[d]); }
        __syncthreads();
    }
#undef DIL_DECODE
#undef DIL_LOAD
}
DI void phase_merge(const Params& p, int wave, int lane) {
    unsigned char* ws = p.ws;
    const int NW = gridDim.x * 8, gw = blockIdx.x * 8 + wave;
    const bf16_t* Q3 = (const bf16_t*)(ws + OFF_Q3); bf16_t* GB = (bf16_t*)(ws + OFF_GB); const float* LSE = (const float*)(ws + OFF_LSE);
    const int head = lane >> 3;
#pragma unroll 1
    for (int row0 = gw * 2; row0 < M; row0 += NW * 2) {
        float l[2][3]; u32x4 a[2][2], bq[2][2], cq[2][2], gg[2][2];
#pragma unroll
        for (int r = 0; r < 2; ++r) { const int row = row0 + r; const size_t off = (size_t)row * 1024 + 16 * lane;
            l[r][0] = LSE[((size_t)row) * 8 + head]; l[r][1] = LSE[((size_t)M + row) * 8 + head]; l[r][2] = LSE[((size_t)2 * M + row) * 8 + head];
#pragma unroll
            for (int hh = 0; hh < 2; ++hh) { a[r][hh] = *(const u32x4*)(Q3 + off + 8 * hh); bq[r][hh] = *(const u32x4*)(Q3 + (size_t)M * 1024 + off + 8 * hh);
                cq[r][hh] = *(const u32x4*)(Q3 + (size_t)2 * M * 1024 + off + 8 * hh); gg[r][hh] = *(const u32x4*)(GB + off + 8 * hh); } }
#pragma unroll
        for (int r = 0; r < 2; ++r) { const size_t off = (size_t)(row0 + r) * 1024 + 16 * lane;
            const float mx = fmaxf(l[r][0], fmaxf(l[r][1], l[r][2])); float w0 = __expf(l[r][0] - mx), w1 = __expf(l[r][1] - mx), w2 = __expf(l[r][2] - mx); const float inv = 1.0f / (w0 + w1 + w2);
            w0 *= inv; w1 *= inv; w2 *= inv;
#pragma unroll
            for (int hh = 0; hh < 2; ++hh) { u32x4 o;
#pragma unroll
                for (int j = 0; j < 4; ++j) { const float lo = (w0 * bflo(a[r][hh][j]) + w1 * bflo(bq[r][hh][j]) + w2 * bflo(cq[r][hh][j])) * bflo(gg[r][hh][j]);
                    const float hi = (w0 * bfhi(a[r][hh][j]) + w1 * bfhi(bq[r][hh][j]) + w2 * bfhi(cq[r][hh][j])) * bfhi(gg[r][hh][j]); o[j] = cvt_pk_bf16(lo, hi); }
                *(u32x4*)(GB + off + 8 * hh) = o; } }
    }
}
DI void phase_final(const Params& p, int wave, int lane) {
    const int NW = gridDim.x * 8, gw = blockIdx.x * 8 + wave;
    float* h = p.out; const float* g = p.in[17];
#pragma unroll 1
    for (int row0 = gw * 4; row0 < M; row0 += NW * 4) {
        f32x4 v[4][4]; float rstd[4];
#pragma unroll
        for (int r = 0; r < 4; ++r)
#pragma unroll
            for (int j = 0; j < 4; ++j) v[r][j] = *((const f32x4*)(h + (size_t)(row0 + r) * 1024) + lane + 64 * j);
#pragma unroll
        for (int r = 0; r < 4; ++r) rstd[r] = 1.0f / sqrtf(wave_sum(row_ss(v[r])) * (1.0f / 1024) + EPS);
#pragma unroll
        for (int j = 0; j < 4; ++j) { const f32x4 gv = *(const f32x4*)(g + 256 * j + 4 * lane);
#pragma unroll
            for (int r = 0; r < 4; ++r) *((f32x4*)(h + (size_t)(row0 + r) * 1024) + lane + 64 * j) = (v[r][j] * rstd[r]) * gv; }
    }
}

#define XB_TMO      128
#define XB_XCNT(j)  (256  + 64 * (j))
#define XB_XSUB(j)  (1280 + 64 * (j))
#define XB_XGEN(j)  (2304 + 64 * (j))
#define XB_TOP      3328
#define XB_TOPGEN   3392
#define XCD_BAR_WORDS 3456
#define XB_SPIN_CAP (1u << 18)

__device__ __forceinline__ unsigned xb_ld(unsigned* p)              { return __hip_atomic_load(p, __ATOMIC_RELAXED, __HIP_MEMORY_SCOPE_AGENT); }
__device__ __forceinline__ unsigned xb_add(unsigned* p, unsigned v) { return __hip_atomic_fetch_add(p, v, __ATOMIC_RELAXED, __HIP_MEMORY_SCOPE_AGENT); }
__device__ __forceinline__ unsigned xb_xcc_id() { return (unsigned)__builtin_amdgcn_s_getreg((3 << 11) | 20) & 0xFu; }
#define XB_SPIN(cond, bar) do { unsigned _sp = 0; while (cond) { __builtin_amdgcn_s_sleep(1); \
    if ((++_sp & 255u) == 0u) { if (xb_ld(&(bar)[XB_TMO])) break; if (_sp > XB_SPIN_CAP) { atomicAdd(&(bar)[XB_TMO], 1u); break; } } } } while (0)

struct XcdBarrier {
    unsigned* bar; unsigned x;
    volatile LAS unsigned* st;
};

__device__ __forceinline__ XcdBarrier xcd_barrier_post(unsigned* bar, volatile LAS unsigned* st, const bool lead) {
    XcdBarrier b; b.bar = bar; b.x = xb_xcc_id(); b.st = st;
    if (lead) (void)xb_add(&bar[XB_XCNT(b.x)], 1u);
    return b;
}
__device__ __forceinline__ void xcd_barrier_complete(unsigned* bar, unsigned x, unsigned& nloc, unsigned& nx) {
    const unsigned G = gridDim.x * gridDim.y * gridDim.z;
    unsigned sum, cnt, mine, sp = 0u;
    for (;;) {
        sum = 0u; cnt = 0u; mine = 0u;
#pragma unroll
        for (unsigned j = 0; j < 16; ++j) { const unsigned c = xb_ld(&bar[XB_XCNT(j)]); sum += c; cnt += (c > 0u) ? 1u : 0u; mine = (j == x) ? c : mine; }
        if (sum == G) break;
        __builtin_amdgcn_s_sleep(1);
        if ((++sp & 255u) == 0u) { if (xb_ld(&bar[XB_TMO])) break; if (sp > XB_SPIN_CAP) { atomicAdd(&bar[XB_TMO], 1u); break; } }
    }
    nloc = mine > 0u ? mine : 1u; nx = cnt > 0u ? cnt : 1u;
}

__device__ __forceinline__ void xcd_barrier(const XcdBarrier& b, const int wave) {
    asm volatile("s_waitcnt vmcnt(0)" ::: "memory");
    __syncthreads();
    if (wave == 0 && pg8::opaque_lane() == 0) {
        unsigned* bar = b.bar;
        __builtin_amdgcn_s_waitcnt(0);
        unsigned nloc = b.st[0], nx = b.st[1];
        if (nloc == 0u) { xcd_barrier_complete(bar, b.x, nloc, nx); b.st[0] = nloc; b.st[1] = nx; }
        const unsigned old = xb_add(&bar[XB_XSUB(b.x)], 1u);
        const unsigned gen = old / nloc;
        if (old + 1u == (gen + 1u) * nloc) {
            __builtin_amdgcn_fence(__ATOMIC_RELEASE, "agent");
            asm volatile("s_waitcnt vmcnt(0)" ::: "memory");
            const unsigned og = xb_add(&bar[XB_TOP], 1u);
            const unsigned tg = og / nx;
            if (og + 1u == (tg + 1u) * nx) xb_add(&bar[XB_TOPGEN], 1u);
            else XB_SPIN(xb_ld(&bar[XB_TOPGEN]) == tg, bar);
            __builtin_amdgcn_fence(__ATOMIC_ACQUIRE, "agent");
            xb_add(&bar[XB_XGEN(b.x)], 1u);
            asm volatile("s_waitcnt vmcnt(0)" ::: "memory");
        } else {
            XB_SPIN(xb_ld(&bar[XB_XGEN(b.x)]) == gen, bar);
            __builtin_amdgcn_fence(__ATOMIC_ACQUIRE, "agent");
            asm volatile("s_waitcnt vmcnt(0)" ::: "memory");
        }
    }
    __syncthreads();
}


extern __shared__ __attribute__((aligned(16))) unsigned char smem_raw[];

__global__ void __launch_bounds__(512) yoco_fwd(Params p) {
    cg::grid_group grid = cg::this_grid();
    LAS unsigned char* lds = (LAS unsigned char*)smem_raw;
    const int wave = __builtin_amdgcn_readfirstlane(threadIdx.x >> 6);
    unsigned char* ws = p.ws;
    pg8::StaticOrder S;
    const int G = gridDim.x, c = blockIdx.x;
    const float* modA = (const float*)(ws + OFF_MOD); const float* modB = modA + (size_t)NB * 3072;
    unsigned* bar = (unsigned*)(ws + OFF_BAR);
    volatile LAS unsigned* xst = (volatile LAS unsigned*)(lds + LDS_BYTES - 16);
    const bool lead_ = (wave == 0) && (pg8::opaque_lane() == 0);
    if (lead_) { xst[0] = 0u; xst[1] = 0u; }
    __syncthreads();
    const XcdBarrier xb = xcd_barrier_post(bar, xst, lead_);
    { { const int lane = pg8::opaque_lane(); phase0(p, lds, wave * 64 + lane, wave, lane); } }
    if (p.ws == nullptr) grid.sync();
    xcd_barrier(xb, wave);
#ifdef PROBE
    if (blockIdx.x == 0 && threadIdx.x == 0) ((unsigned long long*)(ws + OFF_BAR + 32768))[0] = __builtin_amdgcn_s_memrealtime();
#endif
    { { const int lane = pg8::opaque_lane(); phase_hnA(p, wave, lane); } }
    xcd_barrier(xb, wave);
#ifdef PROBE
    if (blockIdx.x == 0 && threadIdx.x == 0) ((unsigned long long*)(ws + OFF_BAR + 32768))[1] = __builtin_amdgcn_s_memrealtime();
#endif
    { {
        { pg8::Gemm g{(const bf16_t*)p.out, (const bf16_t*)(ws + OFF_WA_MAIN), M, 4864, 1024, 2048, 1024, 0, -1}; S.init(M, 4864, G, c);
          EpiAMain E{(bf16_t*)(ws + OFF_QCAT), (bf16_t*)(ws + OFF_GATE), (bf16_t*)(ws + OFF_KEYS), (float*)(ws + OFF_CKV), (const float*)(ws + OFF_ROPE_A), p.in[7], (LAS float*)(lds + 131072)};
          pg8::gemm_phase<EpiAMain, pg8::StaticOrder, false>(lds, g, S, E, nullptr, wave); }
        { pg8::Gemm g{(const bf16_t*)p.out, (const bf16_t*)(ws + OFF_WA_IDX), M, 768, 3072, 2048, 2048, 0, 2}; S.init(M, 768, G, c);
          EpiAIdx E{(bf16_t*)(ws + OFF_QIDX), (bf16_t*)(ws + OFF_KIDX), (float*)(ws + OFF_WIDX), (const float*)(ws + OFF_ROPE_I)};
          pg8::gemm_phase<EpiAIdx, pg8::StaticOrder, true>(lds, g, S, E, nullptr, wave); }
    } }
    xcd_barrier(xb, wave);
#ifdef PROBE
    if (blockIdx.x == 0 && threadIdx.x == 0) ((unsigned long long*)(ws + OFF_BAR + 32768))[2] = __builtin_amdgcn_s_memrealtime();
#endif
    { { const int lane = pg8::opaque_lane(); phase_dsa(p, lds, wave * 64 + lane, wave, lane); } }
    xcd_barrier(xb, wave);
#ifdef PROBE
    if (blockIdx.x == 0 && threadIdx.x == 0) ((unsigned long long*)(ws + OFF_BAR + 32768))[3] = __builtin_amdgcn_s_memrealtime();
#endif
    { { pg8::Gemm g{(const bf16_t*)(ws + OFF_QCAT), (const bf16_t*)(ws + OFF_WUV), M, 2048, 256, 2560, 256, 256, -1}; S.init(M, 2048, G, c);
        EpiUV E{(bf16_t*)(ws + OFF_GATE)}; pg8::gemm_phase<EpiUV, pg8::StaticOrder, false>(lds, g, S, E, nullptr, wave); } }
    xcd_barrier(xb, wave);
#ifdef PROBE
    if (blockIdx.x == 0 && threadIdx.x == 0) ((unsigned long long*)(ws + OFF_BAR + 32768))[4] = __builtin_amdgcn_s_memrealtime();
#endif
    { { pg8::Gemm g{(const bf16_t*)(ws + OFF_GATE), (const bf16_t*)(ws + OFF_WAO), M, 1024, 2048, 2048, 2048, 0, -1}; S.init(M, 1024, G, c);
        EpiRes E{p.in[0], p.out, modA + 2048}; pg8::gemm_phase<EpiRes, pg8::StaticOrder, false>(lds, g, S, E, nullptr, wave); } }
    xcd_barrier(xb, wave);
#ifdef PROBE
    if (blockIdx.x == 0 && threadIdx.x == 0) ((unsigned long long*)(ws + OFF_BAR + 32768))[5] = __builtin_amdgcn_s_memrealtime();
#endif
    { { const int lane = pg8::opaque_lane(); phase_normB(p, wave, lane); } }
    xcd_barrier(xb, wave);
#ifdef PROBE
    if (blockIdx.x == 0 && threadIdx.x == 0) ((unsigned long long*)(ws + OFF_BAR + 32768))[6] = __builtin_amdgcn_s_memrealtime();
#endif
    { { pg8::Gemm g{(const bf16_t*)(ws + OFF_HKV), (const bf16_t*)(ws + OFF_WKV), M, 2048, 1024, 1024, 1024, 0, -1}; S.init(M, 2048, G, c);
        EpiKV E{(bf16_t*)(ws + OFF_KB), (bf16_t*)(ws + OFF_VB), (const float*)(ws + OFF_ROPE_B)}; pg8::gemm_phase<EpiKV, pg8::StaticOrder, false>(lds, g, S, E, nullptr, wave); } }
    xcd_barrier(xb, wave);
#ifdef PROBE
    if (blockIdx.x == 0 && threadIdx.x == 0) ((unsigned long long*)(ws + OFF_BAR + 32768))[7] = __builtin_amdgcn_s_memrealtime();
#endif
    { { pg8::Gemm g{(const bf16_t*)(ws + OFF_HNB), (const bf16_t*)(ws + OFF_WBI), M, 4096, 1024, 1024, 1024, 0, -1}; S.init(M, 4096, G, c);
        EpiBIn E{(bf16_t*)(ws + OFF_Q3), (bf16_t*)(ws + OFF_GB), (const float*)(ws + OFF_ROPE_B)}; pg8::gemm_phase<EpiBIn, pg8::StaticOrder, false>(lds, g, S, E, nullptr, wave); } }
    xcd_barrier(xb, wave);
#ifdef PROBE
    if (blockIdx.x == 0 && threadIdx.x == 0) ((unsigned long long*)(ws + OFF_BAR + 32768))[8] = __builtin_amdgcn_s_memrealtime();
#endif
    { { const int lane = pg8::opaque_lane(); phase_dil(p, lds, wave, lane); } }
    xcd_barrier(xb, wave);
#ifdef PROBE
    if (blockIdx.x == 0 && threadIdx.x == 0) ((unsigned long long*)(ws + OFF_BAR + 32768))[9] = __builtin_amdgcn_s_memrealtime();
#endif
    { { const int lane = pg8::opaque_lane(); phase_merge(p, wave, lane); } }
    xcd_barrier(xb, wave);
#ifdef PROBE
    if (blockIdx.x == 0 && threadIdx.x == 0) ((unsigned long long*)(ws + OFF_BAR + 32768))[10] = __builtin_amdgcn_s_memrealtime();
#endif
    { { pg8::Gemm g{(const bf16_t*)(ws + OFF_GB), (const bf16_t*)(ws + OFF_WBO), M, 1024, 1024, 1024, 1024, 0, -1}; S.init(M, 1024, G, c);
        EpiRes E{p.out, p.out, modB + 2048}; pg8::gemm_phase<EpiRes, pg8::StaticOrder, false>(lds, g, S, E, nullptr, wave); } }
    xcd_barrier(xb, wave);
#ifdef PROBE
    if (blockIdx.x == 0 && threadIdx.x == 0) ((unsigned long long*)(ws + OFF_BAR + 32768))[11] = __builtin_amdgcn_s_memrealtime();
#endif
    { { const int lane = pg8::opaque_lane(); phase_final(p, wave, lane); } }
#ifdef PROBE
    if (blockIdx.x == 0 && threadIdx.x == 0) { const unsigned long long* ts = (const unsigned long long*)(ws + OFF_BAR + 32768); const unsigned* st = (const unsigned*)(ws + OFF_BAR + 16384);
        const float v1 = (float)(ts[PROBE_S1] - ts[PROBE_S0]) * 0.01f;
        const float v2 = (float)st[PROBE_SUB] * 0.01f;
        p.out[0] = v1; if (v2 > 0.f) for (int i = 1; i <= 65536; ++i) p.out[i] = v2; }
#endif
}

extern "C" void kernel_launch(void* const* d_in, const int* in_sizes, int n_in, void* d_out, int out_size, void* d_ws, size_t ws_size, hipStream_t stream) {
    static int grid_blocks = 0;
    if (grid_blocks == 0) {
        if (n_in != 18 || out_size != M * D || ws_size < WS_NEED) { fprintf(stderr, "kernel_launch: unexpected shapes (n_in %d out %d ws %zu need %zu)\n", n_in, out_size, ws_size, (size_t)WS_NEED); grid_blocks = -1; return; }
        int dev = 0, cus = 0, per_cu = 0;
        hipGetDevice(&dev); hipDeviceGetAttribute(&cus, hipDeviceAttributeMultiprocessorCount, dev);
        if (hipFuncSetAttribute((const void*)yoco_fwd, hipFuncAttributeMaxDynamicSharedMemorySize, LDS_BYTES) != hipSuccess) { fprintf(stderr, "kernel_launch: hipFuncSetAttribute failed\n"); grid_blocks = -1; return; }
        if (hipOccupancyMaxActiveBlocksPerMultiprocessor(&per_cu, (const void*)yoco_fwd, 512, LDS_BYTES) != hipSuccess || per_cu < 1) { fprintf(stderr, "kernel_launch: occupancy query gave %d\n", per_cu); per_cu = 1; }
        (void)hipGetLastError();
        grid_blocks = cus * per_cu; if (grid_blocks > MAX_GRID) grid_blocks = MAX_GRID;
    }
    if (grid_blocks < 0) return;
    if (hipMemsetAsync((char*)d_ws + OFF_BAR, 0, XCD_BAR_WORDS * 4, stream) != hipSuccess) { fprintf(stderr, "kernel_launch: memset failed\n"); return; }
    Params p{};
    for (int i = 0; i < 18; ++i) p.in[i] = (const float*)d_in[i];
    p.out = (float*)d_out; p.ws = (unsigned char*)d_ws;
    void* args[] = {&p};
    hipError_t e = hipLaunchCooperativeKernel((const void*)yoco_fwd, dim3(grid_blocks), dim3(512), args, LDS_BYTES, stream);
    if (e != hipSuccess) fprintf(stderr, "cooperative launch failed: %s (grid %d)\n", hipGetErrorString(e), grid_blocks);
}
```
